# Optimizing an MI355X kernel written in HIP

```python
import jax, jax.numpy as jnp
from jax import lax
import numpy as np

D_MODEL = 1024
BATCH = 16
SEQ = 4096
DEPTH = 1
DEC_BATCH = 8
DEC_SEQ = 64
PAST_LEN = 2048

CHUNK = 64
N_META = 16
D_MIX = D_MODEL
RW_HEADS = 8
RW_HEAD = 64
RW_WIDTH = RW_HEADS * RW_HEAD
W_LORA = 64
A_LORA = 64
G_LORA = 128
RW_COLS = 3 * RW_WIDTH + W_LORA + A_LORA + G_LORA
MLA_HEADS = 8
NOPE = 64
ROPE = 32
VDIM = 64
Q_LORA = 256
KV_LORA = 128
MLA_COLS = Q_LORA + KV_LORA + ROPE
N_IN = RW_COLS + MLA_COLS
D_FF = 2816
Q_BLOCK = 128
ROPE_THETA = 10000.0
NORM_EPS = 1e-6
GN_EPS = 64e-5
MLA_SCALE = (NOPE + ROPE) ** -0.5

kernel_name = "hymba_rwkv7_mla_macaron_stream"


def rmsnorm(x, g):
    xf = x.astype(jnp.float32)
    y = xf * lax.rsqrt(jnp.mean(xf * xf, axis=-1, keepdims=True) + NORM_EPS)
    return (y * g.astype(jnp.float32)).astype(x.dtype)


def swiglu(h, w1, w3, w2):
    return (jax.nn.silu(h @ w1) * (h @ w3)) @ w2


def rope(x, pos):
    half = ROPE // 2
    inv = ROPE_THETA ** (-jnp.arange(half, dtype=jnp.float32) / half)
    ang = pos.astype(jnp.float32)[:, None] * inv[None, :]
    shape = (1, pos.shape[0]) + (1,) * (x.ndim - 3) + (half,)
    cos = jnp.cos(ang).reshape(shape)
    sin = jnp.sin(ang).reshape(shape)
    xf = x.astype(jnp.float32)
    x1, x2 = xf[..., :half], xf[..., half:]
    return jnp.concatenate([x1 * cos - x2 * sin, x1 * sin + x2 * cos], axis=-1).astype(x.dtype)


def chunk_id(pos):
    return jnp.where(pos < N_META, -1, (pos - N_META) // CHUNK)


def pre_mix(x, L):
    x = x + 0.5 * swiglu(rmsnorm(x, L["norm_ffn1"]), L["ffn1_w1"], L["ffn1_w3"], L["ffn1_w2"])
    p = rmsnorm(x, L["norm_mix"]) @ L["w_in"]
    return x, p


def rwkv_scan(S0, r, w, k, v, kk, kka):
    def step(S, xs):
        r_t, w_t, k_t, v_t, kk_t, kka_t = xs
        sa = jnp.einsum("bhvk,bhk->bhv", S, -kk_t)
        S = S * w_t[:, :, None, :] + sa[..., None] * kka_t[:, :, None, :] + v_t[..., :, None] * k_t[..., None, :]
        return S, jnp.einsum("bhvk,bhk->bhv", S, r_t)
    xs = tuple(jnp.moveaxis(t, 1, 0) for t in (r, w, k, v, kk, kka))
    S, ys = lax.scan(step, S0, xs)
    return S, jnp.moveaxis(ys, 0, 1)


def rwkv_mix(s, wkv0, L):
    B, T, _ = s.shape
    f = lambda name: L[name].astype(jnp.float32)
    sf = s.astype(jnp.float32)
    cuts = [RW_WIDTH, 2 * RW_WIDTH, 3 * RW_WIDTH, 3 * RW_WIDTH + W_LORA, 3 * RW_WIDTH + W_LORA + A_LORA]
    r, k, v, wl, al, gl = jnp.split(sf, cuts, axis=-1)
    logw = -jax.nn.softplus(-(f("w0") + jnp.tanh(wl) @ f("w_w2"))) - 0.5
    decay = jnp.exp(-jnp.exp(logw))
    a = jax.nn.sigmoid(f("a0") + al @ f("w_a2"))
    g = jax.nn.sigmoid(gl) @ f("w_g2")
    hd = lambda t: t.reshape(B, T, RW_HEADS, RW_HEAD)
    kk = hd(k * f("k_k"))
    kk = kk / jnp.maximum(jnp.sqrt(jnp.sum(kk * kk, axis=-1, keepdims=True)), 1e-12)
    k = k * (1.0 + (a - 1.0) * f("k_a"))
    r, k, v, decay, a = hd(r), hd(k), hd(v), hd(decay), hd(a)
    S, y = rwkv_scan(wkv0.astype(jnp.float32), r, decay, k, v, kk, kk * a)
    mu = jnp.mean(y, axis=-1, keepdims=True)
    var = jnp.mean(jnp.square(y - mu), axis=-1, keepdims=True)
    y = ((y - mu) * lax.rsqrt(var + GN_EPS)).reshape(B, T, RW_WIDTH) * f("ln_x_w") + f("ln_x_b")
    y = y + (jnp.sum(r * k * f("r_k"), axis=-1, keepdims=True) * v).reshape(B, T, RW_WIDTH)
    return (y * g).astype(s.dtype), S.astype(wkv0.dtype)


def mla_kv(p, pos, L):
    o = RW_COLS + Q_LORA
    c = rmsnorm(p[..., o:o + KV_LORA], L["kv_norm"])
    kr = rope(p[..., o + KV_LORA:o + KV_LORA + ROPE], pos)
    return c, kr


def mla_q(p, pos, L):
    cq = rmsnorm(p[..., RW_COLS:RW_COLS + Q_LORA], L["q_norm"])
    q = jnp.einsum("btr,rhd->bthd", cq, L["w_q_up"])
    q_r = rope(q[..., NOPE:], pos)
    q_lat = jnp.einsum("bthd,chd->bthc", q[..., :NOPE], L["w_uk"])
    return q_lat, q_r


def attend(q_lat, q_r, c, kr, mask):
    s = (jnp.einsum("bqhc,bkc->bhqk", q_lat, c) + jnp.einsum("bqhr,bkr->bhqk", q_r, kr)).astype(jnp.float32) * MLA_SCALE
    if mask is not None:
        s = jnp.where(mask, s, -1e30)
    pr = jax.nn.softmax(s, axis=-1).astype(c.dtype)
    return jnp.einsum("bhqk,bkc->bqhc", pr, c)


def prompt_attention(q_lat, q_r, c, kr):
    B, T = q_lat.shape[0], q_lat.shape[1]
    nb = -(-T // Q_BLOCK)
    pad = nb * Q_BLOCK - T
    def blocks(t):
        t = jnp.pad(t, ((0, 0), (0, pad), (0, 0), (0, 0)))
        return jnp.moveaxis(t.reshape((B, nb, Q_BLOCK) + t.shape[2:]), 1, 0)
    cid_k = chunk_id(jnp.arange(T))
    def one(args):
        ql, qr, i = args
        cid_q = chunk_id(i * Q_BLOCK + jnp.arange(Q_BLOCK))
        return attend(ql, qr, c, kr, cid_q[:, None] >= cid_k[None, :])
    out = lax.map(one, (blocks(q_lat), blocks(q_r), jnp.arange(nb)))
    return jnp.moveaxis(out, 0, 1).reshape(B, nb * Q_BLOCK, MLA_HEADS, KV_LORA)[:, :T]


def layer(x, L, pos, shift_prev, wkv0, prefix):
    B, T, _ = x.shape
    x, p = pre_mix(x, L)
    p_rw = p[..., :RW_COLS]
    prev = jnp.concatenate([shift_prev.astype(p.dtype), p_rw[:, :-1]], axis=1)
    rw_out, wkv = rwkv_mix(p_rw + L["mu_shift"] * (prev - p_rw), wkv0, L)
    c, kr = mla_kv(p, pos, L)
    q_lat, q_r = mla_q(p, pos, L)
    if prefix is None:
        lat = prompt_attention(q_lat, q_r, c, kr)
    else:
        c_all = jnp.concatenate([prefix[0].astype(c.dtype), c], axis=1)
        kr_all = jnp.concatenate([prefix[1].astype(kr.dtype), kr], axis=1)
        lat = attend(q_lat, q_r, c_all, kr_all, None)
    mla_out = jnp.einsum("bqhc,chd->bqhd", lat, L["w_uv"]).reshape(B, T, MLA_HEADS * VDIM)
    x = x + jnp.concatenate([rw_out, mla_out], axis=-1) @ L["w_out"]
    x = x + 0.5 * swiglu(rmsnorm(x, L["norm_ffn2"]), L["ffn2_w1"], L["ffn2_w3"], L["ffn2_w2"])
    return x, p_rw[:, -1:], wkv, c, kr


def setup_inputs(seed: int = 0) -> dict:
    key = jax.random.key(seed)
    ks = list(jax.random.split(key, 40))
    cnt = [0]
    def nk():
        cnt[0] += 1
        return ks[cnt[0] - 1]
    f32 = jnp.float32
    def nrm(shape, scale=1.0):
        return jax.random.normal(nk(), shape, f32) * scale
    def gain(shape):
        return 1.0 + nrm(shape, 0.01)
    return {
        "x_prompt": nrm((BATCH, SEQ, D_MODEL)),
        "x_sample": nrm((DEC_BATCH, DEC_SEQ, D_MODEL)),
        "cache_ckv": nrm((DEPTH, DEC_BATCH, PAST_LEN, KV_LORA)),
        "cache_krope": nrm((DEPTH, DEC_BATCH, PAST_LEN, ROPE)),
        "state_wkv": nrm((DEPTH, DEC_BATCH, RW_HEADS, RW_HEAD, RW_HEAD), 0.3),
        "state_shift": nrm((DEPTH, DEC_BATCH, 1, RW_COLS)),
        "meta_tokens": nrm((N_META, D_MODEL)),
        "norm_ffn1": gain((DEPTH, D_MODEL)),
        "ffn1_w1": nrm((DEPTH, D_MODEL, D_FF), D_MODEL ** -0.5),
        "ffn1_w3": nrm((DEPTH, D_MODEL, D_FF), D_MODEL ** -0.5),
        "ffn1_w2": nrm((DEPTH, D_FF, D_MODEL), D_FF ** -0.5),
        "norm_mix": gain((DEPTH, D_MODEL)),
        "w_in": nrm((DEPTH, D_MODEL, N_IN), D_MODEL ** -0.5),
        "mu_shift": jax.random.uniform(nk(), (DEPTH, RW_COLS), f32),
        "w0": nrm((DEPTH, RW_WIDTH), 0.5),
        "w_w2": nrm((DEPTH, W_LORA, RW_WIDTH), W_LORA ** -0.5),
        "a0": nrm((DEPTH, RW_WIDTH), 0.1),
        "w_a2": nrm((DEPTH, A_LORA, RW_WIDTH), 0.5 * A_LORA ** -0.5),
        "w_g2": nrm((DEPTH, G_LORA, RW_WIDTH), G_LORA ** -0.5),
        "k_k": 1.0 + nrm((DEPTH, RW_WIDTH), 0.1),
        "k_a": 1.0 + nrm((DEPTH, RW_WIDTH), 0.1),
        "r_k": nrm((DEPTH, RW_HEADS, RW_HEAD), 0.1),
        "ln_x_w": gain((DEPTH, RW_WIDTH)),
        "ln_x_b": nrm((DEPTH, RW_WIDTH), 0.01),
        "q_norm": gain((DEPTH, Q_LORA)),
        "w_q_up": nrm((DEPTH, Q_LORA, MLA_HEADS, NOPE + ROPE), Q_LORA ** -0.5),
        "kv_norm": gain((DEPTH, KV_LORA)),
        "w_uk": nrm((DEPTH, KV_LORA, MLA_HEADS, NOPE), KV_LORA ** -0.5),
        "w_uv": nrm((DEPTH, KV_LORA, MLA_HEADS, VDIM), KV_LORA ** -0.5),
        "w_out": nrm((DEPTH, D_MIX, D_MODEL), D_MIX ** -0.5),
        "norm_ffn2": gain((DEPTH, D_MODEL)),
        "ffn2_w1": nrm((DEPTH, D_MODEL, D_FF), D_MODEL ** -0.5),
        "ffn2_w3": nrm((DEPTH, D_MODEL, D_FF), D_MODEL ** -0.5),
        "ffn2_w2": nrm((DEPTH, D_FF, D_MODEL), D_FF ** -0.5),
        "final_norm": gain((D_MODEL,)),
    }


def reference(x_prompt, x_sample, cache_ckv, cache_krope, state_wkv, state_shift, meta_tokens,
              norm_ffn1, ffn1_w1, ffn1_w3, ffn1_w2, norm_mix, w_in, mu_shift, w0, w_w2, a0, w_a2,
              w_g2, k_k, k_a, r_k, ln_x_w, ln_x_b, q_norm, w_q_up, kv_norm, w_uk, w_uv, w_out,
              norm_ffn2, ffn2_w1, ffn2_w3, ffn2_w2, final_norm):
    P = dict(norm_ffn1=norm_ffn1, ffn1_w1=ffn1_w1, ffn1_w3=ffn1_w3, ffn1_w2=ffn1_w2, norm_mix=norm_mix,
             w_in=w_in, mu_shift=mu_shift, w0=w0, w_w2=w_w2, a0=a0, w_a2=w_a2, w_g2=w_g2, k_k=k_k,
             k_a=k_a, r_k=r_k, ln_x_w=ln_x_w, ln_x_b=ln_x_b, q_norm=q_norm, w_q_up=w_q_up,
             kv_norm=kv_norm, w_uk=w_uk, w_uv=w_uv, w_out=w_out, norm_ffn2=norm_ffn2,
             ffn2_w1=ffn2_w1, ffn2_w3=ffn2_w3, ffn2_w2=ffn2_w2)
    B, S_len, _ = x_prompt.shape
    Bd, Tn, _ = x_sample.shape
    past = cache_ckv.shape[2]
    dt = x_prompt.dtype
    meta = meta_tokens.astype(dt)
    x = jnp.concatenate([jnp.broadcast_to(meta[None], (B, N_META, D_MODEL)), x_prompt], axis=1)
    xs = x_sample
    m = meta[None]
    pos_p = jnp.arange(N_META + S_len)
    pos_m = jnp.arange(N_META)
    pos_s = N_META + past + jnp.arange(Tn)
    ckv_p, kr_p, wkv_p, sh_p = [], [], [], []
    ckv_s, kr_s, wkv_s, sh_s = [], [], [], []
    for l in range(DEPTH):
        L = {name: arr[l] for name, arr in P.items()}
        x, sh, wkv, c, kr = layer(x, L, pos_p, jnp.zeros((B, 1, RW_COLS), dt),
                                  jnp.zeros((B, RW_HEADS, RW_HEAD, RW_HEAD), dt), None)
        ckv_p.append(c); kr_p.append(kr); wkv_p.append(wkv); sh_p.append(sh)
        _, p_m = pre_mix(m, L)
        c_m, kr_m = mla_kv(p_m, pos_m, L)
        prefix = (jnp.concatenate([jnp.broadcast_to(c_m, (Bd, N_META, KV_LORA)), cache_ckv[l].astype(c_m.dtype)], axis=1),
                  jnp.concatenate([jnp.broadcast_to(kr_m, (Bd, N_META, ROPE)), cache_krope[l].astype(kr_m.dtype)], axis=1))
        xs, sh2, wkv2, c2, kr2 = layer(xs, L, pos_s, state_shift[l], state_wkv[l], prefix)
        ckv_s.append(c2); kr_s.append(kr2); wkv_s.append(wkv2); sh_s.append(sh2)
        if l + 1 < DEPTH:
            m = layer(m, L, pos_m, jnp.zeros((1, 1, RW_COLS), dt),
                      jnp.zeros((1, RW_HEADS, RW_HEAD, RW_HEAD), dt), None)[0]
    y_prompt = rmsnorm(x, final_norm)[:, N_META:]
    y_sample = rmsnorm(xs, final_norm)
    return (y_prompt, y_sample,
            jnp.stack(ckv_p), jnp.stack(kr_p), jnp.stack(wkv_p), jnp.stack(sh_p),
            jnp.stack(ckv_s), jnp.stack(kr_s), jnp.stack(wkv_s), jnp.stack(sh_s))
```

```cpp
#include <hip/hip_runtime.h>
#include <hip/hip_cooperative_groups.h>
#include <cstdio>
#include <type_traits>
namespace cg = cooperative_groups;

typedef unsigned short u16;
typedef unsigned int u32;
using bf16x8 = __attribute__((ext_vector_type(8))) short;
using f32x4 = __attribute__((ext_vector_type(4))) float;
using u32x4 = __attribute__((ext_vector_type(4))) unsigned;
using u32x2 = __attribute__((ext_vector_type(2))) unsigned;
#define DI __device__ __forceinline__

#ifndef PHASE_MASK
#define PHASE_MASK 0x7ff
#endif
#define PH_ON(x) ((PHASE_MASK >> (x)) & 1)
#ifndef NCH_UP
#define NCH_UP 4
#endif
#ifndef NCH_DOWN
#define NCH_DOWN 0
#endif
#ifndef NCH_WIN
#define NCH_WIN 2
#endif
#ifndef NCH_OUT
#define NCH_OUT 0
#endif
#ifndef RES_MF
#define RES_MF 8
#endif
#ifndef ONE_LAUNCH
#define ONE_LAUNCH 1
#endif

constexpr int D = 1024;
constexpr int TP = 4112;
constexpr int M_P = 16 * TP;
constexpr int M_TOT = M_P + 512;
constexpr int DFF = 2816;
constexpr int NIN = 2208;
constexpr int NINP = 2304;
constexpr int KS_S = 2128;
constexpr int KS_TOT = M_TOT + 8 * KS_S;
constexpr int KS_ALLOC = 326 * 256 + 256;
constexpr int TPAD_P = 4352;
constexpr int TPAD_S = 2304;
constexpr int NTHREADS = 512;
constexpr int NWAVES = 8;

constexpr long O_YP = 0;
constexpr long O_YS = O_YP + 16L * 4096 * 1024;
constexpr long O_CKVP = O_YS + 8L * 64 * 1024;
constexpr long O_KRP = O_CKVP + 16L * TP * 128;
constexpr long O_WKVP = O_KRP + 16L * TP * 32;
constexpr long O_SHP = O_WKVP + 16L * 8 * 64 * 64;
constexpr long O_CKVS = O_SHP + 16L * 1792;
constexpr long O_KRS = O_CKVS + 8L * 64 * 128;
constexpr long O_WKVS = O_KRS + 8L * 64 * 32;
constexpr long O_SHS = O_WKVS + 8L * 8 * 64 * 64;

constexpr size_t al256(size_t x) { return (x + 255) & ~size_t(255); }
constexpr size_t WS_ZERO = 0;
constexpr size_t WS_XBAR = WS_ZERO + 256 + 4 * (size_t)M_TOT * 4;
constexpr size_t ZERO_BYTES = al256(256 + 4 * (size_t)M_TOT * 4 + 3456 * 4);
constexpr size_t WS_ROPE = WS_ZERO + ZERO_BYTES;
constexpr size_t WS_W13A = WS_ROPE + al256((size_t)TP * 16 * 8);
constexpr size_t WS_W2A = WS_W13A + (size_t)2 * DFF * D * 2;
constexpr size_t WS_WIN = WS_W2A + (size_t)D * DFF * 2;
constexpr size_t WS_WOUT = WS_WIN + (size_t)NINP * D * 2;
constexpr size_t WS_W13B = WS_WOUT + (size_t)D * D * 2;
constexpr size_t WS_W2B = WS_W13B + (size_t)2 * DFF * D * 2;
constexpr size_t WS_WQ = WS_W2B + (size_t)D * DFF * 2;
constexpr size_t WS_WUK = WS_WQ + (size_t)768 * 256 * 2;
constexpr size_t WS_WUV = WS_WUK + (size_t)512 * 128 * 2;
constexpr size_t WS_WW2 = WS_WUV + (size_t)512 * 128 * 2;
constexpr size_t WS_WA2 = WS_WW2 + (size_t)512 * 64 * 2;
constexpr size_t WS_WG2 = WS_WA2 + (size_t)512 * 64 * 2;
constexpr size_t WS_XB = al256(WS_WG2 + (size_t)512 * 128 * 2);
constexpr size_t WS_ACT = WS_XB + (size_t)M_TOT * D * 2;
constexpr size_t ACT_BYTES = (size_t)M_TOT * DFF * 2;
constexpr size_t WS_P = WS_ACT + ACT_BYTES;
constexpr size_t WS_MIX = WS_P + al256((size_t)M_TOT * NIN * 2);
constexpr size_t WS_CQN = WS_MIX + (size_t)M_TOT * D * 2;
constexpr size_t WS_CB = WS_CQN + (size_t)M_TOT * 256 * 2;
constexpr size_t WS_END = WS_CB + (size_t)KS_ALLOC * 128 * 2;
constexpr size_t WS_Q = WS_ACT;
constexpr size_t WS_KALL = WS_Q + (size_t)M_TOT * 768 * 2;
constexpr size_t WS_VTP = WS_KALL + (size_t)KS_ALLOC * 768 * 2;
constexpr size_t WS_VTS = WS_VTP + (size_t)16 * 512 * TPAD_P * 2;
constexpr size_t WS_ALIAS_END = WS_VTS + (size_t)8 * 512 * TPAD_S * 2;
static_assert(WS_ALIAS_END <= WS_ACT + ACT_BYTES, "alias region overflow");
static_assert(WS_END <= (size_t)1 << 30, "workspace too large");

constexpr int SMEM_BYTES = 131072;

struct Params {
  const float* in[35];
  float* out;
  unsigned char* ws;
};

DI u32 pack2(float a, float b);
DI u16 f2bf(float f) { return (u16)(pack2(f, 0.f) & 0xffffu); }
DI float bf2f(u16 h) { return __uint_as_float(((u32)h) << 16); }
typedef float f32x2_t __attribute__((ext_vector_type(2)));
typedef __bf16 bf16x2_t __attribute__((ext_vector_type(2)));
DI u32 pack2(float a, float b) {
  f32x2_t v = {a, b};
  bf16x2_t r = __builtin_convertvector(v, bf16x2_t);
  return __builtin_bit_cast(u32, r);
}
DI float bflo(u32 v) { return __uint_as_float(v << 16); }
DI float bfhi(u32 v) { return __uint_as_float(v & 0xffff0000u); }
DI float wave_sum(float v) {
#pragma unroll
  for (int o = 32; o >= 1; o >>= 1) v += __shfl_xor(v, o);
  return v;
}
template <int CTRL> DI float dpp_f(float v) {
  return __int_as_float(__builtin_amdgcn_update_dpp(0, __float_as_int(v), CTRL, 0xf, 0xf, false));
}
DI float row16_sum(float v) {
  v += dpp_f<0xB1>(v);
  v += dpp_f<0x4E>(v);
  v += dpp_f<0x141>(v);
  v += dpp_f<0x140>(v);
  return v;
}
DI float frcp(float x) { return __builtin_amdgcn_rcpf(x); }
DI float sigmoidf_(float x) { return frcp(1.f + __expf(-x)); }
DI float siluf_(float x) { return x * frcp(1.f + __expf(-x)); }
DI int row_pos(int row) { return row < M_P ? row % TP : 2064 + ((row - M_P) & 63); }
DI int swz(int r, int c4) { return r * 64 + ((c4 ^ ((r >> 3) << 1)) << 4); }
DI f32x4 mfma16(bf16x8 a, bf16x8 b, f32x4 c) { return __builtin_amdgcn_mfma_f32_16x16x32_bf16(a, b, c, 0, 0, 0); }

struct TJob { const float* src; int K, N, Npad; size_t dst; const float* gain; float scale; int mode; };
DI void transpose_tile(const Params& p, const TJob& j, int kt, int nt, float* sm, bool active) {
  const float* src = j.src;
  const float* gain = j.gain;
  u16* dst = (u16*)(p.ws + j.dst);
  const int tid = threadIdx.x & 255;
  sm += (threadIdx.x >> 8) * (64 * 65);
  __syncthreads();
  if (active) {
#pragma unroll
  for (int i = 0; i < 16; ++i) {
    int idx = tid + i * 256;
    int kk = idx >> 6, nn = idx & 63;
    int k = kt * 64 + kk, n = nt * 64 + nn;
    float v = 0.f;
    if (n < j.N) {
      v = src[(size_t)k * j.N + n] * j.scale;
      if (gain) v *= gain[k];
    }
    sm[kk * 65 + nn] = v;
  }
  }
  __syncthreads();
  if (active) {
    int nn = tid >> 2, kq = (tid & 3) * 16;
    int n = nt * 64 + nn;
    int drow = n;
    if (j.mode == 3) {
      const int c = n & 63;
      drow = (n & ~63) + 16 * ((c & 15) >> 2) + 4 * (c >> 4) + (c & 3);
    } else if (j.mode) {
      const int a = n & 31;
      drow = ((n >> 5) << 6) + ((((a & 7) >> 2) * 2 + (j.mode == 2 ? 1 : 0)) << 4) + 4 * (a >> 3) + (a & 3);
    }
    u32 w[8];
#pragma unroll
    for (int i = 0; i < 8; ++i) w[i] = pack2(sm[(kq + 2 * i) * 65 + nn], sm[(kq + 2 * i + 1) * 65 + nn]);
    u32x4* d = (u32x4*)(dst + (size_t)drow * j.K + kt * 64 + kq);
    u32x4 a = {w[0], w[1], w[2], w[3]}, b = {w[4], w[5], w[6], w[7]};
    d[0] = a; d[1] = b;
  }
}

__device__ __forceinline__ void phase_prep(const Params& p, unsigned char* smem) {
  float* sm = (float*)smem;
  const float qs = 0.10206207261596577f * 1.4426950408889634f;
  auto get_job = [&](int ji) -> TJob {
    switch (ji) {
      case 0: return TJob{p.in[8], D, DFF, DFF, WS_W13A, p.in[7], 1.f, 1};
      case 1: return TJob{p.in[9], D, DFF, DFF, WS_W13A, p.in[7], 1.f, 2};
      case 2: return TJob{p.in[10], DFF, D, D, WS_W2A, nullptr, 1.f, 3};
      case 3: return TJob{p.in[12], D, NIN, NINP, WS_WIN, p.in[11], 1.f, 3};
      case 4: return TJob{p.in[29], D, D, D, WS_WOUT, nullptr, 1.f, 3};
      case 5: return TJob{p.in[31], D, DFF, DFF, WS_W13B, p.in[30], 1.f, 1};
      case 6: return TJob{p.in[32], D, DFF, DFF, WS_W13B, p.in[30], 1.f, 2};
      case 7: return TJob{p.in[33], DFF, D, D, WS_W2B, nullptr, 1.f, 3};
      case 8: return TJob{p.in[25], 256, 768, 768, WS_WQ, p.in[24], qs, 0};
      case 9: return TJob{p.in[27], 128, 512, 512, WS_WUK, nullptr, 1.f, 3};
      case 10: return TJob{p.in[28], 128, 512, 512, WS_WUV, nullptr, 1.f, 0};
      case 11: return TJob{p.in[15], 64, 512, 512, WS_WW2, nullptr, 1.f, 0};
      case 12: return TJob{p.in[17], 64, 512, 512, WS_WA2, nullptr, 1.f, 0};
      default: return TJob{p.in[18], 128, 512, 512, WS_WG2, nullptr, 1.f, 0};
    }
  };
  int base = 0;
#pragma unroll 1
  for (int ji = 0; ji < 14; ++ji) {
    const TJob j = get_job(ji);
    int nkt = j.K / 64, nnt = j.Npad / 64;
    int cnt = nkt * nnt;
    int first = ((int)blockIdx.x - base % (int)gridDim.x + (int)gridDim.x) % (int)gridDim.x;
    for (int t = first; t < cnt; t += 2 * gridDim.x) {
      const int tt = t + (int)(threadIdx.x >> 8) * (int)gridDim.x;
      transpose_tile(p, j, tt % nkt, tt / nkt, sm, tt < cnt);
    }
    base += cnt;
  }
  {
    u16* xb = (u16*)(p.ws + WS_XB);
    float* ssq1 = (float*)(p.ws + WS_ZERO + 256);
    const int lane = threadIdx.x & 63, wave = threadIdx.x >> 6;
    const int rstride = gridDim.x * NWAVES;
    for (int row = blockIdx.x * NWAVES + wave; row < M_TOT; row += 2 * rstride) {
      const float* src[2]; int rows[2]; bool ok[2];
#pragma unroll
      for (int u = 0; u < 2; ++u) {
        int rw = row + u * rstride; ok[u] = rw < M_TOT; if (!ok[u]) rw = row; rows[u] = rw;
        if (rw < M_P) {
          int b = rw / TP, pp = rw % TP;
          src[u] = pp < 16 ? p.in[6] + (size_t)pp * D : p.in[0] + ((size_t)b * 4096 + (pp - 16)) * D;
        } else src[u] = p.in[1] + (size_t)(rw - M_P) * D;
      }
      float4 v[2][4];
#pragma unroll
      for (int u = 0; u < 2; ++u)
#pragma unroll
        for (int i = 0; i < 4; ++i) v[u][i] = *(const float4*)(src[u] + i * 256 + lane * 4);
#pragma unroll
      for (int u = 0; u < 2; ++u) {
        float sacc = 0.f;
#pragma unroll
        for (int i = 0; i < 4; ++i) {
          const float4 t = v[u][i];
          sacc += t.x * t.x + t.y * t.y + t.z * t.z + t.w * t.w;
          u32x2 o = {pack2(t.x, t.y), pack2(t.z, t.w)};
          if (ok[u]) *(u32x2*)(xb + (size_t)rows[u] * D + i * 256 + lane * 4) = o;
        }
        sacc = wave_sum(sacc);
        if (lane == 0 && ok[u]) ssq1[rows[u]] = sacc;
      }
    }
  }
  {
    float2* rt = (float2*)(p.ws + WS_ROPE);
    for (int i = blockIdx.x * NTHREADS + threadIdx.x; i < TP * 16; i += gridDim.x * NTHREADS) {
      int pos = i >> 4, f = i & 15;
      float inv = exp2f(-(float)f * (13.287712379549449f / 16.f));
      float ang = (float)pos * inv;
      float rev = ang * 0.15915494309189535f;
      rev = rev - rintf(rev);
      rt[i] = make_float2(__builtin_amdgcn_cosf(rev), __builtin_amdgcn_sinf(rev));
    }
  }
}

struct GemmArgs { const u16* A; long lda; const u16* B; long ldb; int K; };
enum { EPI_FFNUP = 0, EPI_RESID = 1, EPI_WIN = 2, EPI_FINAL = 3, EPI_Q = 4, EPI_KN = 5, EPI_VT = 6 };
struct EpiArgs {
  const float* ssq_in;
  float* ssq_out;
  u16* dst; long ldd;
  float alpha;
  float* out;
  const float2* rope;
  int rows_valid;
};

template <int EPI, int MF>
__device__ __forceinline__ void gemm_tile(const GemmArgs g, const int m0, const int n0, unsigned char* smem, const EpiArgs e,
                                          const bool preloaded = false, const bool has_next = false, const int nm0 = 0, const int nn0 = 0) {
  const int tid = threadIdx.x, lane = tid & 63, wave = tid >> 6;
  const int wm = wave >> 2, wn = wave & 3, r = lane & 15, q = lane >> 4;
  f32x4 acc[MF][4];
#pragma unroll
  for (int m = 0; m < MF; ++m)
#pragma unroll
    for (int n = 0; n < 4; ++n) acc[m][n] = (f32x4){0.f, 0.f, 0.f, 0.f};
  constexpr int APW = MF / 2;
  const int pr = lane >> 3, pc = (lane & 7) ^ (lane >> 3);
  const u16* ag = g.A + (size_t)(m0 + wave * (APW * 8) + pr) * g.lda + pc * 8;
  const u16* bg = g.B + (size_t)(n0 + wave * 32 + pr) * g.ldb + pc * 8;
  const int rr = r & 7;
  const int lbase = ((r >> 3) << 10) + (rr << 7);
  const int lofs0 = lbase + ((q ^ rr) << 4), lofs1 = lbase + (((4 + q) ^ rr) << 4);
  typedef void __attribute__((address_space(3))) * lds_ptr;
  const unsigned lds_base = (unsigned)(unsigned long)((lds_ptr)smem);
  const int nk = g.K >> 6;
  if (!preloaded) __syncthreads();
#define GEMM_PIECE_A(BUF, I) __builtin_amdgcn_global_load_lds((const void*)(ag + (size_t)(I) * 8 * g.lda), (lds_ptr)(smem + (BUF) * 65536 + (wave * APW + (I)) * 1024 + lane * 16), 16, 0, 0)
#define GEMM_PIECE_B(BUF, I) __builtin_amdgcn_global_load_lds((const void*)(bg + (size_t)(I) * 8 * g.ldb), (lds_ptr)(smem + (BUF) * 65536 + 32768 + (wave * 4 + (I)) * 1024 + lane * 16), 16, 0, 0)
#define GEMM_STAGE(BUF)                                                    \
  do {                                                                     \
    _Pragma("unroll") for (int i = 0; i < APW; ++i) GEMM_PIECE_A(BUF, i);  \
    _Pragma("unroll") for (int i = 0; i < 4; ++i) GEMM_PIECE_B(BUF, i);    \
    ag += 64; bg += 64;                                                    \
  } while (0)
#define GEMM_WAIT0 asm volatile("s_waitcnt vmcnt(0)\n\ts_barrier" ::: "memory")
  if (preloaded) { ag += 64; bg += 64; }
  else GEMM_STAGE(0);
  GEMM_WAIT0;
  int buf = 0;
#pragma unroll 1
  for (int kt = 0; kt < nk; ++kt) {
    const bool issue = kt + 1 < nk;
    const int ibuf = buf ^ 1;
#pragma unroll
    for (int s2 = 0; s2 < 2; ++s2) {
      bf16x8 bf[4], af[MF];
      {
        const unsigned la = lds_base + buf * 65536 + ((wm * MF) << 11) + (s2 ? lofs1 : lofs0);
        const unsigned lb = lds_base + buf * 65536 + 32768 + ((wn * 4) << 11) + (s2 ? lofs1 : lofs0);
        if constexpr (MF == 8) {
          asm volatile(
              "ds_read_b128 %0, %13\n\tds_read_b128 %1, %13 offset:2048\n\tds_read_b128 %2, %13 offset:4096\n\tds_read_b128 %3, %13 offset:6144\n\t"
              "ds_read_b128 %4, %12\n\tds_read_b128 %5, %12 offset:2048\n\tds_read_b128 %6, %12 offset:4096\n\tds_read_b128 %7, %12 offset:6144\n\t"
              "ds_read_b128 %8, %12 offset:8192\n\tds_read_b128 %9, %12 offset:10240\n\tds_read_b128 %10, %12 offset:12288\n\tds_read_b128 %11, %12 offset:14336\n\t"
              "s_waitcnt lgkmcnt(0)"
              : "=&v"(bf[0]), "=&v"(bf[1]), "=&v"(bf[2]), "=&v"(bf[3]), "=&v"(af[0]), "=&v"(af[1]), "=&v"(af[2]), "=&v"(af[3]),
                "=&v"(af[4]), "=&v"(af[5]), "=&v"(af[6]), "=&v"(af[7])
              : "v"(la), "v"(lb)
              : "memory");
        } else {
          asm volatile(
              "ds_read_b128 %0, %9\n\tds_read_b128 %1, %9 offset:2048\n\tds_read_b128 %2, %9 offset:4096\n\tds_read_b128 %3, %9 offset:6144\n\t"
              "ds_read_b128 %4, %8\n\tds_read_b128 %5, %8 offset:2048\n\tds_read_b128 %6, %8 offset:4096\n\tds_read_b128 %7, %8 offset:6144\n\t"
              "s_waitcnt lgkmcnt(0)"
              : "=&v"(bf[0]), "=&v"(bf[1]), "=&v"(bf[2]), "=&v"(bf[3]), "=&v"(af[0]), "=&v"(af[1]), "=&v"(af[2]), "=&v"(af[3])
              : "v"(la), "v"(lb)
              : "memory");
        }
      }
      __builtin_amdgcn_sched_barrier(0);
      __builtin_amdgcn_s_setprio(1);
#pragma unroll
      for (int m = 0; m < MF; ++m) {
#pragma unroll
        for (int n = 0; n < 4; ++n) acc[m][n] = mfma16(bf[n], af[m], acc[m][n]);
        if constexpr (MF == 8) {
          if (m & 1) {
            __builtin_amdgcn_sched_barrier(0);
            if (issue) {
              if (s2 == 0) { if (m == 1) GEMM_PIECE_A(ibuf, 0); if (m == 3) GEMM_PIECE_A(ibuf, 1); if (m == 5) GEMM_PIECE_A(ibuf, 2); if (m == 7) GEMM_PIECE_A(ibuf, 3); }
              else { if (m == 1) GEMM_PIECE_B(ibuf, 0); if (m == 3) GEMM_PIECE_B(ibuf, 1); if (m == 5) GEMM_PIECE_B(ibuf, 2); if (m == 7) GEMM_PIECE_B(ibuf, 3); }
            }
            __builtin_amdgcn_sched_barrier(0);
          }
        } else {
          if (m < 3) {
            __builtin_amdgcn_sched_barrier(0);
            if (issue) {
              if (s2 == 0) { if (m == 0) GEMM_PIECE_A(ibuf, 0); if (m == 1) GEMM_PIECE_A(ibuf, 1); if (m == 2) GEMM_PIECE_B(ibuf, 0); }
              else { if (m == 0) GEMM_PIECE_B(ibuf, 1); if (m == 1) GEMM_PIECE_B(ibuf, 2); if (m == 2) GEMM_PIECE_B(ibuf, 3); }
            }
            __builtin_amdgcn_sched_barrier(0);
          }
        }
      }
      __builtin_amdgcn_s_setprio(0);
      __builtin_amdgcn_sched_barrier(0);
    }
    if (issue) { ag += 64; bg += 64; }
    GEMM_WAIT0;
    buf ^= 1;
  }
  const int rbase = m0 + wm * (MF * 16) + r;
  const int cbase = n0 + wn * 64 + q * 4;
  const int cb16 = n0 + wn * 64 + q * 16;
  float rsv[MF];
  constexpr bool PRE_X = (EPI == EPI_RESID || EPI == EPI_FINAL) && MF == 4;
  float xv[PRE_X ? MF : 1][16];
  if constexpr (EPI == EPI_FFNUP || EPI == EPI_WIN) {
#pragma unroll
    for (int m = 0; m < MF; ++m) rsv[m] = rsqrtf(e.ssq_in[rbase + m * 16] * (1.f / 1024.f) + 1e-6f);
  }
  if constexpr (PRE_X) {
    u32x4 xin[MF][2];
#pragma unroll
    for (int m = 0; m < MF; ++m) {
      const u16* xp = e.dst + (size_t)(rbase + m * 16) * e.ldd + cb16;
      xin[m][0] = *(const u32x4*)xp; xin[m][1] = *(const u32x4*)(xp + 8);
    }
#pragma unroll
    for (int m = 0; m < MF; ++m) {
#pragma unroll
      for (int i = 0; i < 4; ++i) {
        xv[m][2 * i] = bflo(xin[m][0][i]); xv[m][2 * i + 1] = bfhi(xin[m][0][i]);
        xv[m][8 + 2 * i] = bflo(xin[m][1][i]); xv[m][8 + 2 * i + 1] = bfhi(xin[m][1][i]);
      }
#pragma unroll
      for (int n = 0; n < 4; ++n)
#pragma unroll
        for (int j = 0; j < 4; ++j) xv[m][4 * n + j] += e.alpha * acc[m][n][j];
    }
  }
  if constexpr (EPI == EPI_FFNUP || EPI == EPI_WIN) {
#pragma unroll
    for (int m = 0; m < MF; ++m) asm volatile("" :: "v"(rsv[m]));
  }
  if constexpr (PRE_X) {
#pragma unroll
    for (int m = 0; m < MF; ++m)
      asm volatile("" :: "v"(xv[m][0]), "v"(xv[m][1]), "v"(xv[m][2]), "v"(xv[m][3]), "v"(xv[m][4]), "v"(xv[m][5]), "v"(xv[m][6]), "v"(xv[m][7]),
                   "v"(xv[m][8]), "v"(xv[m][9]), "v"(xv[m][10]), "v"(xv[m][11]), "v"(xv[m][12]), "v"(xv[m][13]), "v"(xv[m][14]), "v"(xv[m][15]));
  }
  __builtin_amdgcn_sched_barrier(0);
  if (has_next) {
    ag = g.A + (size_t)(nm0 + wave * (APW * 8) + pr) * g.lda + pc * 8;
    bg = g.B + (size_t)(nn0 + wave * 32 + pr) * g.ldb + pc * 8;
    GEMM_STAGE(0);
  }
  __builtin_amdgcn_sched_barrier(0);
#undef GEMM_STAGE
#undef GEMM_WAIT0
#undef GEMM_PIECE_A
#undef GEMM_PIECE_B
  if constexpr (EPI == EPI_FFNUP) {
#pragma unroll
    for (int m = 0; m < MF; ++m) {
      const int row = rbase + m * 16;
      const float rs = rsv[m];
      const int col = ((n0 + wn * 64) >> 1) + q * 8;
      float o[8];
#pragma unroll
      for (int pr = 0; pr < 2; ++pr)
#pragma unroll
        for (int j = 0; j < 4; ++j) o[pr * 4 + j] = siluf_(acc[m][2 * pr][j] * rs) * (acc[m][2 * pr + 1][j] * rs);
      u32x4 v = {pack2(o[0], o[1]), pack2(o[2], o[3]), pack2(o[4], o[5]), pack2(o[6], o[7])};
      *(u32x4*)(e.dst + (size_t)row * e.ldd + col) = v;
    }
  } else if constexpr (EPI == EPI_RESID || EPI == EPI_FINAL) {
#pragma unroll
    for (int m = 0; m < MF; ++m) {
      const int row = rbase + m * 16;
      float ss = 0.f;
      float* yrow = nullptr;
      if constexpr (EPI == EPI_FINAL) {
        if (row < M_P) {
          int b = row / TP, pp = row % TP;
          if (pp >= 16) yrow = e.out + O_YP + ((size_t)b * 4096 + (pp - 16)) * 1024;
        } else yrow = e.out + O_YS + (size_t)(row - M_P) * 1024;
      }
      u16* xp = e.dst + (size_t)row * e.ldd + cb16;
      float x[16];
      if constexpr (PRE_X) {
#pragma unroll
        for (int i = 0; i < 16; ++i) x[i] = xv[m][i];
      } else {
        const u32x4 xa = *(const u32x4*)xp, xb = *(const u32x4*)(xp + 8);
#pragma unroll
        for (int i = 0; i < 4; ++i) {
          x[2 * i] = bflo(xa[i]); x[2 * i + 1] = bfhi(xa[i]);
          x[8 + 2 * i] = bflo(xb[i]); x[8 + 2 * i + 1] = bfhi(xb[i]);
        }
#pragma unroll
        for (int n = 0; n < 4; ++n)
#pragma unroll
          for (int j = 0; j < 4; ++j) x[4 * n + j] += e.alpha * acc[m][n][j];
      }
      if constexpr (EPI == EPI_RESID) {
        u32x4 va = {pack2(x[0], x[1]), pack2(x[2], x[3]), pack2(x[4], x[5]), pack2(x[6], x[7])};
        u32x4 vb = {pack2(x[8], x[9]), pack2(x[10], x[11]), pack2(x[12], x[13]), pack2(x[14], x[15])};
        *(u32x4*)xp = va; *(u32x4*)(xp + 8) = vb;
#pragma unroll
        for (int i = 0; i < 4; ++i) {
          x[2 * i] = bflo(va[i]); x[2 * i + 1] = bfhi(va[i]);
          x[8 + 2 * i] = bflo(vb[i]); x[8 + 2 * i + 1] = bfhi(vb[i]);
        }
      } else {
        if (yrow) {
#pragma unroll
          for (int i = 0; i < 4; ++i) *(float4*)(yrow + cb16 + 4 * i) = make_float4(x[4 * i], x[4 * i + 1], x[4 * i + 2], x[4 * i + 3]);
        }
      }
#pragma unroll
      for (int i = 0; i < 16; ++i) ss += x[i] * x[i];
      ss += __shfl_xor(ss, 16);
      ss += __shfl_xor(ss, 32);
      if (q == 0) atomicAdd(e.ssq_out + row, ss);
    }
  } else if constexpr (EPI == EPI_WIN) {
#pragma unroll
    for (int m = 0; m < MF; ++m) {
      const int row = rbase + m * 16;
      const float rs = rsv[m];
      float* sh = nullptr;
      if (row < M_P) { if (row % TP == TP - 1) sh = e.out + O_SHP + (size_t)(row / TP) * 1792; }
      else if (((row - M_P) & 63) == 63) sh = e.out + O_SHS + (size_t)((row - M_P) >> 6) * 1792;
      if (cb16 < NIN) {
        float x[16];
#pragma unroll
        for (int n = 0; n < 4; ++n)
#pragma unroll
          for (int j = 0; j < 4; ++j) x[4 * n + j] = acc[m][n][j] * rs;
        u32x4 va = {pack2(x[0], x[1]), pack2(x[2], x[3]), pack2(x[4], x[5]), pack2(x[6], x[7])};
        u32x4 vb = {pack2(x[8], x[9]), pack2(x[10], x[11]), pack2(x[12], x[13]), pack2(x[14], x[15])};
        u16* dp = e.dst + (size_t)row * e.ldd + cb16;
        *(u32x4*)dp = va; *(u32x4*)(dp + 8) = vb;
        if (sh && cb16 < 1792) {
#pragma unroll
          for (int i = 0; i < 4; ++i) *(float4*)(sh + cb16 + 4 * i) = make_float4(x[4 * i], x[4 * i + 1], x[4 * i + 2], x[4 * i + 3]);
        }
      }
    }
  } else if constexpr (EPI == EPI_Q) {
#pragma unroll
    for (int m = 0; m < MF; ++m) {
      const int row = rbase + m * 16;
      const int pos = row_pos(row);
#pragma unroll
      for (int n = 0; n < 4; ++n) {
        const int col = cbase + n * 16;
        const int hc = col % 96;
        float v0 = acc[m][n][0], v1 = acc[m][n][1], v2 = acc[m][n][2], v3 = acc[m][n][3];
        if (hc >= 64) {
          const int f0 = (hc - 64) & 15;
          const float4 cs01 = *(const float4*)(e.rope + pos * 16 + f0);
          const float4 cs23 = *(const float4*)(e.rope + pos * 16 + f0 + 2);
          if (hc < 80) {
            if (n < 3) {
              const f32x4 o = acc[m][n < 3 ? n + 1 : n];
              v0 = v0 * cs01.x - o[0] * cs01.y; v1 = v1 * cs01.z - o[1] * cs01.w;
              v2 = v2 * cs23.x - o[2] * cs23.y; v3 = v3 * cs23.z - o[3] * cs23.w;
            }
          } else {
            if (n > 0) {
              const f32x4 o = acc[m][n > 0 ? n - 1 : n];
              v0 = o[0] * cs01.y + v0 * cs01.x; v1 = o[1] * cs01.w + v1 * cs01.z;
              v2 = o[2] * cs23.y + v2 * cs23.x; v3 = o[3] * cs23.w + v3 * cs23.z;
            }
          }
        }
        u32x2 v = {pack2(v0, v1), pack2(v2, v3)};
        *(u32x2*)(e.dst + (size_t)row * e.ldd + col) = v;
      }
    }
  } else if constexpr (EPI == EPI_KN) {
#pragma unroll
    for (int m = 0; m < MF; ++m) {
      const int row = rbase + m * 16;
      if (row < e.rows_valid) {
        const int h = cb16 >> 6, d = cb16 & 63;
        u32x4 va = {pack2(acc[m][0][0], acc[m][0][1]), pack2(acc[m][0][2], acc[m][0][3]), pack2(acc[m][1][0], acc[m][1][1]), pack2(acc[m][1][2], acc[m][1][3])};
        u32x4 vb = {pack2(acc[m][2][0], acc[m][2][1]), pack2(acc[m][2][2], acc[m][2][3]), pack2(acc[m][3][0], acc[m][3][1]), pack2(acc[m][3][2], acc[m][3][3])};
        u16* dp = e.dst + (size_t)row * 768 + h * 96 + d;
        *(u32x4*)dp = va; *(u32x4*)(dp + 8) = vb;
      }
    }
  } else if constexpr (EPI == EPI_VT) {
#pragma unroll
    for (int m = 0; m < MF; ++m) {
      const int row = rbase + m * 16;
#pragma unroll
      for (int n = 0; n < 4; ++n) {
        const int col = cbase + n * 16;
        u32x2 v = {pack2(acc[m][n][0], acc[m][n][1]), pack2(acc[m][n][2], acc[m][n][3])};
        *(u32x2*)(e.dst + (size_t)row * e.ldd + col) = v;
      }
    }
  }
}

struct XcdInfo { int xcd, slot, nbx; };
template <int EPI, int MF>
__device__ __forceinline__ void gemm_phase(const GemmArgs g, const EpiArgs e, int mtiles, int ntiles, unsigned char* smem, const XcdInfo xi, const int nchunk, const int m_base = 0) {
  const int nb = gridDim.x;
  constexpr int BM = MF * 32;
  const bool can_pre = !((EPI == EPI_RESID || EPI == EPI_FINAL) && MF == 8);
  if (xi.nbx > 0) {
    const int xcd = xi.xcd, slot = xi.slot, nbx = xi.nbx;
    const int mloc = (mtiles + 7) >> 3;
    constexpr int GS = 2;
    const int mgroups = (mloc + GS - 1) / GS;
    const int total = nchunk == 0 ? mgroups * GS * ntiles : mloc * ntiles;
    auto decode = [&](int L, int& m, int& n) {
      if (nchunk == 0) {
        const int mg = L / (GS * ntiles), rem = L % (GS * ntiles);
        m = (mg * GS + (rem & (GS - 1))) * 8 + xcd; n = rem / GS;
      } else {
        int c = 0;
#pragma unroll
        for (int cc = 1; cc < 4; ++cc) if (cc < nchunk && L >= mloc * ((cc * ntiles) / nchunk)) c = cc;
        const int ns = (c * ntiles) / nchunk, ne = ((c + 1) * ntiles) / nchunk, cn = ne - ns;
        const int rem = L - mloc * ns;
        m = (rem / cn) * 8 + xcd; n = ns + rem % cn;
      }
    };
    auto tile_m = [&](int L) { int m, n; decode(L, m, n); return m; };
    auto tile_n = [&](int L) { int m, n; decode(L, m, n); return n; };
    auto next_valid = [&](int L) { while (L < total && tile_m(L) >= mtiles) L += nbx; return L; };
    int L = next_valid(slot);
    bool pre = false;
    while (L < total) {
      const int Ln = next_valid(L + nbx);
      const bool hn = can_pre && Ln < total;
      gemm_tile<EPI, MF>(g, m_base + tile_m(L) * BM, tile_n(L) * 256, smem, e, pre, hn, hn ? m_base + tile_m(Ln) * BM : 0, hn ? tile_n(Ln) * 256 : 0);
      pre = hn; L = Ln;
    }
  } else {
    const int total = mtiles * ntiles;
    int t = blockIdx.x;
    bool pre = false;
    while (t < total) {
      const int tn = t + nb;
      const bool hn = can_pre && tn < total;
      gemm_tile<EPI, MF>(g, m_base + (t / ntiles) * BM, (t % ntiles) * 256, smem, e, pre, hn, hn ? m_base + (tn / ntiles) * BM : 0, hn ? (tn % ntiles) * 256 : 0);
      pre = hn; t = tn;
    }
  }
}

__device__ __forceinline__ void phase_mla_prep(const Params& p) {
  const u16* P = (const u16*)(p.ws + WS_P);
  u16* CQN = (u16*)(p.ws + WS_CQN);
  u16* CB = (u16*)(p.ws + WS_CB);
  u16* KALL = (u16*)(p.ws + WS_KALL);
  const float2* rope = (const float2*)(p.ws + WS_ROPE);
  const float* gkv = p.in[26];
  const int lane = threadIdx.x & 63, wave = threadIdx.x >> 6;
  const float g0 = gkv[lane * 2], g1 = gkv[lane * 2 + 1];
  const int rstride = gridDim.x * NWAVES;
  for (int row0 = blockIdx.x * NWAVES + wave; row0 < KS_TOT; row0 += 2 * rstride) {
    int rows[2], prow[2], pos[2]; bool ok[2];
    u32x2 qv[2]; u32 cv[2]; float x1[2], x2[2]; float2 cs[2]; float cf0[2], cf1[2], kf0[2], kf1[2];
#pragma unroll
    for (int u = 0; u < 2; ++u) {
      int row = row0 + u * rstride; ok[u] = row < KS_TOT; if (!ok[u]) row = row0; rows[u] = row;
      prow[u] = -1; pos[u] = 0; int cache_idx = 0;
      if (row < M_TOT) { prow[u] = row; pos[u] = row_pos(row); }
      else {
        int sr = row - M_TOT, bd = sr / KS_S, idx = sr % KS_S;
        pos[u] = idx;
        if (idx < 16) prow[u] = idx;
        else if (idx >= 2064) prow[u] = M_P + bd * 64 + (idx - 2064);
        else cache_idx = bd * 2048 + (idx - 16);
      }
      qv[u] = (u32x2){0u, 0u}; cv[u] = 0u; x1[u] = x2[u] = 0.f; cs[u] = make_float2(1.f, 0.f); cf0[u] = cf1[u] = kf0[u] = kf1[u] = 0.f;
      if (prow[u] >= 0) {
        const u16* pr = P + (size_t)prow[u] * NIN;
        if (row < M_TOT) qv[u] = *(const u32x2*)(pr + 1792 + lane * 4);
        cv[u] = *(const u32*)(pr + 2048 + lane * 2);
        if (lane < 16) { x1[u] = bf2f(pr[2176 + lane]); x2[u] = bf2f(pr[2176 + 16 + lane]); cs[u] = rope[pos[u] * 16 + lane]; }
      } else {
        const float* cc = p.in[2] + (size_t)cache_idx * 128;
        cf0[u] = cc[lane * 2]; cf1[u] = cc[lane * 2 + 1];
        if (lane < 16) { const float* kr = p.in[3] + (size_t)cache_idx * 32; kf0[u] = kr[lane]; kf1[u] = kr[lane + 16]; }
      }
    }
#pragma unroll
    for (int u = 0; u < 2; ++u) {
      const int row = rows[u];
      float c0, c1, k0 = 0.f, k1 = 0.f;
      if (prow[u] >= 0) {
        if (row < M_TOT) {
          float a0 = bflo(qv[u][0]), a1 = bfhi(qv[u][0]), a2 = bflo(qv[u][1]), a3 = bfhi(qv[u][1]);
          float s = wave_sum(a0 * a0 + a1 * a1 + a2 * a2 + a3 * a3);
          float rs = rsqrtf(s * (1.f / 256.f) + 1e-6f);
          u32x2 o = {pack2(a0 * rs, a1 * rs), pack2(a2 * rs, a3 * rs)};
          if (ok[u]) *(u32x2*)(CQN + (size_t)row * 256 + lane * 4) = o;
        }
        c0 = bflo(cv[u]); c1 = bfhi(cv[u]);
        float s = wave_sum(c0 * c0 + c1 * c1);
        float rs = rsqrtf(s * (1.f / 128.f) + 1e-6f);
        c0 = c0 * rs * g0; c1 = c1 * rs * g1;
        if (lane < 16) { k0 = x1[u] * cs[u].x - x2[u] * cs[u].y; k1 = x1[u] * cs[u].y + x2[u] * cs[u].x; }
      } else {
        c0 = cf0[u]; c1 = cf1[u]; k0 = kf0[u]; k1 = kf1[u];
      }
      if (ok[u]) {
        *(u32*)(CB + (size_t)row * 128 + lane * 2) = pack2(c0, c1);
        {
          const u32 pk01 = pack2(k0, k1);
          const int hsel = lane >> 3, part = lane & 7;
          u32 g4[4];
#pragma unroll
          for (int jj = 0; jj < 4; ++jj) g4[jj] = (u32)__shfl((int)pk01, (part * 4 + jj) & 15);
          u32 lo, hi;
          if (part < 4) { lo = (g4[0] & 0xffffu) | (g4[1] << 16); hi = (g4[2] & 0xffffu) | (g4[3] << 16); }
          else { lo = (g4[0] >> 16) | (g4[1] & 0xffff0000u); hi = (g4[2] >> 16) | (g4[3] & 0xffff0000u); }
          const u32x2 kv = {lo, hi};
          *(u32x2*)(KALL + (size_t)row * 768 + hsel * 96 + 64 + part * 4) = kv;
        }
        if (row < M_TOT) {
          float* oc; float* okp;
          if (row < M_P) { oc = p.out + O_CKVP + (size_t)row * 128; okp = p.out + O_KRP + (size_t)row * 32; }
          else { oc = p.out + O_CKVS + (size_t)(row - M_P) * 128; okp = p.out + O_KRS + (size_t)(row - M_P) * 32; }
          *(float2*)(oc + lane * 2) = make_float2(c0, c1);
          if (lane < 16) { okp[lane] = k0; okp[lane + 16] = k1; }
        }
      }
    }
  }
}

__device__ __forceinline__ void phase_mla_gemms(const Params& p, unsigned char* smem) {
  const int T_Q = 259 * 3, T_K = 326 * 2, T_VP = 16 * 2 * 17, T_VS = 8 * 2 * 9;
  const int total = T_Q + T_K + T_VP + T_VS;
  for (int t = blockIdx.x; t < total; t += gridDim.x) {
    if (t < T_Q) {
      GemmArgs g{(const u16*)(p.ws + WS_CQN), 256, (const u16*)(p.ws + WS_WQ), 256, 256};
      EpiArgs e{}; e.dst = (u16*)(p.ws + WS_Q); e.ldd = 768; e.rope = (const float2*)(p.ws + WS_ROPE);
      gemm_tile<EPI_Q, 8>(g, (t / 3) * 256, (t % 3) * 256, smem, e);
    } else if (t < T_Q + T_K) {
      int u = t - T_Q;
      GemmArgs g{(const u16*)(p.ws + WS_CB), 128, (const u16*)(p.ws + WS_WUK), 128, 128};
      EpiArgs e{}; e.dst = (u16*)(p.ws + WS_KALL); e.rows_valid = KS_TOT;
      gemm_tile<EPI_KN, 8>(g, (u >> 1) * 256, (u & 1) * 256, smem, e);
    } else {
      int u = t - T_Q - T_K;
      int s, mt, nt; long rowbase; u16* dst; long ldd;
      if (u < T_VP) { s = u / 34; int v = u % 34; mt = v / 17; nt = v % 17; rowbase = (long)s * TP;
        dst = (u16*)(p.ws + WS_VTP) + (size_t)s * 512 * TPAD_P; ldd = TPAD_P; }
      else { u -= T_VP; s = u / 18; int v = u % 18; mt = v / 9; nt = v % 9; rowbase = (long)M_TOT + (long)s * KS_S;
        dst = (u16*)(p.ws + WS_VTS) + (size_t)s * 512 * TPAD_S; ldd = TPAD_S; }
      GemmArgs g{(const u16*)(p.ws + WS_WUV), 128, (const u16*)(p.ws + WS_CB) + rowbase * 128, 128, 128};
      EpiArgs e{}; e.dst = dst; e.ldd = ldd;
      gemm_tile<EPI_VT, 8>(g, mt * 256, nt * 256, smem, e);
    }
  }
}

DI int vswz(int r, int c4) { return r * 64 + ((c4 ^ (r >> 2)) << 4); }

struct AttnItem {
  const u16* Q; const u16* Kb; const u16* Vt; long ldv;
  u16* O; int nq_valid; int ntiles;
  int wt_base, wt_step;
};

__device__ __forceinline__ void attn_item(const AttnItem it, unsigned char* smem) {
  int tid = threadIdx.x;
  asm volatile("" : "+v"(tid));
  const int lane = tid & 63, wave = tid >> 6;
  const int r = lane & 15, q = lane >> 4;
  const int my_tiles = it.wt_base + (wave >> 1) * it.wt_step;
  bf16x8 qf[2][3];
#pragma unroll
  for (int f = 0; f < 2; ++f) {
    int qr = wave * 32 + f * 16 + r;
    if (qr >= it.nq_valid) qr = it.nq_valid - 1;
#pragma unroll
    for (int ks = 0; ks < 3; ++ks) qf[f][ks] = *(const bf16x8*)(it.Q + (size_t)qr * 768 + ks * 32 + q * 8);
  }
  f32x4 o[4][2];
#pragma unroll
  for (int d = 0; d < 4; ++d)
#pragma unroll
    for (int f = 0; f < 2; ++f) o[d][f] = (f32x4){0.f, 0.f, 0.f, 0.f};
  float mrun[2] = {-1e30f, -1e30f}, lrun[2] = {0.f, 0.f};
  u32x4 rk[2], rv;
  int kofs[2], vofs;
  const u16* kptr[2]; const u16* vptr;
  const bool k2 = tid < 256;
#pragma unroll
  for (int i = 0; i < 2; ++i) {
    int c = tid + i * 512; if (c >= 768) c = 767; int key = c / 12, kc = c % 12;
    kptr[i] = it.Kb + (size_t)key * 768 + kc * 8;
    kofs[i] = (((key >> 4) * 3 + (kc >> 2)) << 10) + swz(key & 15, kc & 3);
  }
  {
    int c = tid; int dv = c >> 3, kc = c & 7;
    vptr = it.Vt + (size_t)dv * it.ldv + kc * 8;
    vofs = (((dv >> 4) * 2 + (kc >> 2)) << 10) + vswz(dv & 15, kc & 3);
  }
  const int nt_all = it.ntiles + 1;
  rk[0] = *(const u32x4*)(kptr[0]);
  rk[1] = *(const u32x4*)(kptr[1]);
  rv = *(const u32x4*)(vptr);
  __syncthreads();
  {
    unsigned char* sK = smem; unsigned char* sV = smem + 12288;
    *(u32x4*)(sK + kofs[0]) = rk[0];
    if (k2) *(u32x4*)(sK + kofs[1]) = rk[1];
    *(u32x4*)(sV + vofs) = rv;
  }
  __syncthreads();
  auto tile_body = [&](auto meta_tag, const unsigned char* sK, const unsigned char* sV) {
    constexpr bool META = decltype(meta_tag)::value;
    constexpr int NKF = META ? 1 : 4;
    constexpr int NKS = META ? 1 : 2;
    f32x4 s[NKF][2];
#pragma unroll
    for (int kf = 0; kf < NKF; ++kf)
#pragma unroll
      for (int f = 0; f < 2; ++f) s[kf][f] = (f32x4){0.f, 0.f, 0.f, 0.f};
#pragma unroll
    for (int kf = 0; kf < NKF; ++kf) {
#pragma unroll
      for (int ks = 0; ks < 3; ++ks) {
        bf16x8 kfr = *(const bf16x8*)(sK + ((kf * 3 + ks) << 10) + swz(r, q));
#pragma unroll
        for (int f = 0; f < 2; ++f) s[kf][f] = mfma16(kfr, qf[f][ks], s[kf][f]);
      }
    }
    float mx[2];
#pragma unroll
    for (int f = 0; f < 2; ++f) {
      float m_ = s[0][f][0];
#pragma unroll
      for (int kf = 0; kf < NKF; ++kf)
#pragma unroll
        for (int j = 0; j < 4; ++j) m_ = fmaxf(m_, s[kf][f][j]);
      m_ = fmaxf(m_, __shfl_xor(m_, 16));
      m_ = fmaxf(m_, __shfl_xor(m_, 32));
      mx[f] = m_;
    }
    const bool need = (mx[0] > mrun[0] + 8.f) || (mx[1] > mrun[1] + 8.f);
    if (__builtin_amdgcn_ballot_w64(need) != 0ull) {
#pragma unroll
      for (int f = 0; f < 2; ++f) {
        const float mnew = fmaxf(mrun[f], mx[f]);
        const float alpha = __builtin_amdgcn_exp2f(mrun[f] - mnew);
        mrun[f] = mnew;
        lrun[f] *= alpha;
#pragma unroll
        for (int d = 0; d < 4; ++d)
#pragma unroll
          for (int j = 0; j < 4; ++j) o[d][f][j] *= alpha;
      }
    }
    bf16x8 pf[2][NKS];
#pragma unroll
    for (int f = 0; f < 2; ++f) {
      float pv[NKF][4];
      float ps = 0.f;
#pragma unroll
      for (int kf = 0; kf < NKF; ++kf)
#pragma unroll
        for (int j = 0; j < 4; ++j) { pv[kf][j] = __builtin_amdgcn_exp2f(s[kf][f][j] - mrun[f]); ps += pv[kf][j]; }
      lrun[f] += ps;
      if constexpr (META) {
        u32x4 w = {pack2(pv[0][0], pv[0][1]), pack2(pv[0][2], pv[0][3]), 0u, 0u};
        pf[f][0] = __builtin_bit_cast(bf16x8, w);
      } else {
#pragma unroll
        for (int ks = 0; ks < 2; ++ks) {
          u32x4 w = {pack2(pv[2 * ks][0], pv[2 * ks][1]), pack2(pv[2 * ks][2], pv[2 * ks][3]),
                     pack2(pv[2 * ks + 1][0], pv[2 * ks + 1][1]), pack2(pv[2 * ks + 1][2], pv[2 * ks + 1][3])};
          pf[f][ks] = __builtin_bit_cast(bf16x8, w);
        }
      }
    }
#pragma unroll
    for (int ks = 0; ks < NKS; ++ks) {
#pragma unroll
      for (int d = 0; d < 4; ++d) {
        const unsigned char* vb = sV + ((d * 2 + ks) << 10) + r * 64;
        const int x = (r >> 2) << 1;
        u32x2 lo = *(const u32x2*)(vb + (((q) ^ x) << 3));
        u32x2 hi = *(const u32x2*)(vb + (((4 + q) ^ x) << 3));
        u32x4 w = {lo[0], lo[1], hi[0], hi[1]};
        bf16x8 vf = __builtin_bit_cast(bf16x8, w);
#pragma unroll
        for (int f = 0; f < 2; ++f) o[d][f] = mfma16(vf, pf[f][ks], o[d][f]);
      }
    }
  };
#pragma unroll 1
  for (int ti = 0; ti < nt_all; ++ti) {
    unsigned char* sK = smem + (ti & 1) * 20480; unsigned char* sV = sK + 12288;
    if (ti + 1 < nt_all) {
      const long koff = 16 + 64 * (long)ti;
      rk[0] = *(const u32x4*)(kptr[0] + koff * 768);
      rk[1] = *(const u32x4*)(kptr[1] + koff * 768);
      rv = *(const u32x4*)(vptr + koff);
    }
    if (ti == 0) tile_body(std::true_type{}, sK, sV);
    else if (ti <= my_tiles) tile_body(std::false_type{}, sK, sV);
    if (ti + 1 < nt_all) {
      unsigned char* nK = smem + ((ti + 1) & 1) * 20480; unsigned char* nV = nK + 12288;
      *(u32x4*)(nK + kofs[0]) = rk[0];
      if (k2) *(u32x4*)(nK + kofs[1]) = rk[1];
      *(u32x4*)(nV + vofs) = rv;
    }
    __syncthreads();
  }
#pragma unroll
  for (int f = 0; f < 2; ++f) {
    float l = lrun[f];
    l += __shfl_xor(l, 16);
    l += __shfl_xor(l, 32);
    const float inv = 1.f / l;
    const int qr = wave * 32 + f * 16 + r;
    if (qr < it.nq_valid) {
#pragma unroll
      for (int d = 0; d < 4; ++d) {
        u32x2 v = {pack2(o[d][f][0] * inv, o[d][f][1] * inv), pack2(o[d][f][2] * inv, o[d][f][3] * inv)};
        *(u32x2*)(it.O + (size_t)qr * 1024 + d * 16 + q * 4) = v;
      }
    }
  }
}

__device__ __forceinline__ void scan_item(const Params& p, int stream, int h, unsigned char* smem) {
  int tid = threadIdx.x;
  asm volatile("" : "+v"(tid));
  const int hf = tid >> 8;
  unsigned char* const smem0 = smem;
  smem += hf * 61440;
  tid &= 255;
  const int lane = tid & 63, wave = tid >> 6;
  const int r = lane & 15, q = lane >> 4;
  const bool is_p = stream < 16;
  const int T = is_p ? TP : 64;
  const long row0 = is_p ? (long)stream * TP : (long)M_P + (long)(stream - 16) * 64;
  const u16* P = (const u16*)(p.ws + WS_P);
  u16* MIX = (u16*)(p.ws + WS_MIX);
  const float* mu = p.in[13];
  const float* shift0 = is_p ? nullptr : p.in[5] + (size_t)(stream - 16) * 1792;
  float* sW = (float*)smem;
  float* sKp = sW + 1024;
  float* sNKK = sKp + 1024;
  float* sKKA = sNKK + 1024;
  float* sR = sKKA + 1024;
  float* sV = sR + 1024;
  float* sG = sV + 1024;
  float* sY = sG + 1024;
  float* sRK = sY + 1024;
  unsigned char* sTW = (unsigned char*)(sRK + 64);
  unsigned char* sAL = sTW + 2048;
  unsigned char* sSG = sAL + 2048;
  unsigned char* imgA = sSG + 4096;
  unsigned char* imgR = imgA + 2304;
  unsigned char* imgB = imgR + 2304;
  unsigned char* imgK = imgB + 2304;
  unsigned char* sBKT = imgK + 2304;
  unsigned char* sMAT = sBKT + 4608;
  float* sNab = (float*)(sMAT + 2560);
  float* sGam = sNab + 256;
  unsigned char* sTT = (unsigned char*)(sGam + 64);
  const int chw = h * 64 + wave * 16 + r;
  bf16x8 bw[2], ba[2], bg[4];
  {
    const u16* Ww = (const u16*)(p.ws + WS_WW2) + (size_t)chw * 64;
    const u16* Wa = (const u16*)(p.ws + WS_WA2) + (size_t)chw * 64;
    const u16* Wg = (const u16*)(p.ws + WS_WG2) + (size_t)chw * 128;
#pragma unroll
    for (int ks = 0; ks < 2; ++ks) { bw[ks] = *(const bf16x8*)(Ww + ks * 32 + q * 8); ba[ks] = *(const bf16x8*)(Wa + ks * 32 + q * 8); }
#pragma unroll
    for (int ks = 0; ks < 4; ++ks) bg[ks] = *(const bf16x8*)(Wg + ks * 32 + q * 8);
  }
  const float w0c = p.in[14][chw], a0c = p.in[16][chw];
  const int et = tid >> 4, ec = (tid & 15) * 4;
  const int hc = h * 64 + ec;
  const int lseg = (tid & 15) * 16;
  float S[4][4];
  const int vme = wave * 16 + r;
  if (is_p) {
#pragma unroll
    for (int g = 0; g < 4; ++g)
#pragma unroll
      for (int j = 0; j < 4; ++j) S[g][j] = 0.f;
  } else {
    const float* st = p.in[4] + ((size_t)(stream - 16) * 8 + h) * 4096;
#pragma unroll
    for (int g = 0; g < 4; ++g) {
      float4 v = *(const float4*)(st + vme * 64 + g * 16 + q * 4);
      S[g][0] = v.x; S[g][1] = v.y; S[g][2] = v.z; S[g][3] = v.w;
    }
  }
  u32x2 g_cr, g_pr, g_ck, g_pk, g_cv, g_pv;
  u32x4 g_cl0, g_cl1, g_pl0, g_pl1;
#define SCAN_LOAD(T0)                                                              \
  do {                                                                             \
    long _row = row0 + (T0) + et; if (_row > M_TOT - 1) _row = M_TOT - 1;          \
    long _prow = _row > 0 ? _row - 1 : 0;                                          \
    const u16* _pc = P + (size_t)_row * NIN; const u16* _pp = P + (size_t)_prow * NIN; \
    g_cr = *(const u32x2*)(_pc + hc); g_pr = *(const u32x2*)(_pp + hc);            \
    g_ck = *(const u32x2*)(_pc + 512 + hc); g_pk = *(const u32x2*)(_pp + 512 + hc); \
    g_cv = *(const u32x2*)(_pc + 1024 + hc); g_pv = *(const u32x2*)(_pp + 1024 + hc); \
    g_cl0 = *(const u32x4*)(_pc + 1536 + lseg); g_cl1 = *(const u32x4*)(_pc + 1536 + lseg + 8); \
    g_pl0 = *(const u32x4*)(_pp + 1536 + lseg); g_pl1 = *(const u32x4*)(_pp + 1536 + lseg + 8); \
  } while (0)
  SCAN_LOAD(16 * hf);
  __syncthreads();
#pragma unroll 1
  for (int tb = 0; tb < T; tb += 32) {
    const int t0 = tb + 16 * hf;
    {
      float mu_r[4], mu_k[4], mu_v[4];
      {
        const float4 a4 = *(const float4*)(mu + hc), b4 = *(const float4*)(mu + 512 + hc), c4v = *(const float4*)(mu + 1024 + hc);
        mu_r[0] = a4.x; mu_r[1] = a4.y; mu_r[2] = a4.z; mu_r[3] = a4.w;
        mu_k[0] = b4.x; mu_k[1] = b4.y; mu_k[2] = b4.z; mu_k[3] = b4.w;
        mu_v[0] = c4v.x; mu_v[1] = c4v.y; mu_v[2] = c4v.z; mu_v[3] = c4v.w;
      }
      const bool first = (t0 + et) == 0;
      float rr[4], kk_[4], vv[4];
      {
        u32x2 c = g_cr, pv = first ? (u32x2){0u, 0u} : g_pr;
        float cf[4] = {bflo(c[0]), bfhi(c[0]), bflo(c[1]), bfhi(c[1])};
        float pf[4] = {bflo(pv[0]), bfhi(pv[0]), bflo(pv[1]), bfhi(pv[1])};
        if (first && shift0) { float4 s4 = *(const float4*)(shift0 + hc); pf[0] = s4.x; pf[1] = s4.y; pf[2] = s4.z; pf[3] = s4.w; }
#pragma unroll
        for (int j = 0; j < 4; ++j) rr[j] = cf[j] + mu_r[j] * (pf[j] - cf[j]);
      }
      {
        u32x2 c = g_ck, pv = first ? (u32x2){0u, 0u} : g_pk;
        float cf[4] = {bflo(c[0]), bfhi(c[0]), bflo(c[1]), bfhi(c[1])};
        float pf[4] = {bflo(pv[0]), bfhi(pv[0]), bflo(pv[1]), bfhi(pv[1])};
        if (first && shift0) { float4 s4 = *(const float4*)(shift0 + 512 + hc); pf[0] = s4.x; pf[1] = s4.y; pf[2] = s4.z; pf[3] = s4.w; }
#pragma unroll
        for (int j = 0; j < 4; ++j) kk_[j] = cf[j] + mu_k[j] * (pf[j] - cf[j]);
      }
      {
        u32x2 c = g_cv, pv = first ? (u32x2){0u, 0u} : g_pv;
        float cf[4] = {bflo(c[0]), bfhi(c[0]), bflo(c[1]), bfhi(c[1])};
        float pf[4] = {bflo(pv[0]), bfhi(pv[0]), bflo(pv[1]), bfhi(pv[1])};
        if (first && shift0) { float4 s4 = *(const float4*)(shift0 + 1024 + hc); pf[0] = s4.x; pf[1] = s4.y; pf[2] = s4.z; pf[3] = s4.w; }
#pragma unroll
        for (int j = 0; j < 4; ++j) vv[j] = cf[j] + mu_v[j] * (pf[j] - cf[j]);
      }
      *(float4*)(sR + et * 64 + ec) = make_float4(rr[0], rr[1], rr[2], rr[3]);
      *(float4*)(sKp + et * 64 + ec) = make_float4(kk_[0], kk_[1], kk_[2], kk_[3]);
      *(float4*)(sV + et * 64 + ec) = make_float4(vv[0], vv[1], vv[2], vv[3]);
      {
        unsigned char* base; int kcol;
        if (lseg < 64) { base = sTW; kcol = lseg; }
        else if (lseg < 128) { base = sAL; kcol = lseg - 64; }
        else { base = sSG; kcol = lseg - 128; }
        const int st = kcol >> 5, c4 = (kcol & 31) >> 3;
#pragma unroll
        for (int hf = 0; hf < 2; ++hf) {
          const u32x4 cc = hf ? g_cl1 : g_cl0;
          u32x4 pq = {0u, 0u, 0u, 0u};
          if (!first) pq = hf ? g_pl1 : g_pl0;
          float cf[8], pf[8], lv[8];
#pragma unroll
          for (int j = 0; j < 4; ++j) {
            cf[2 * j] = bflo(cc[j]); cf[2 * j + 1] = bfhi(cc[j]);
            pf[2 * j] = bflo(pq[j]); pf[2 * j + 1] = bfhi(pq[j]);
          }
          if (first && shift0) {
#pragma unroll
            for (int j = 0; j < 8; ++j) pf[j] = shift0[1536 + lseg + hf * 8 + j];
          }
          const float4 m0 = *(const float4*)(mu + 1536 + lseg + hf * 8), m1 = *(const float4*)(mu + 1536 + lseg + hf * 8 + 4);
          const float mul[8] = {m0.x, m0.y, m0.z, m0.w, m1.x, m1.y, m1.z, m1.w};
          const float act_s = lseg < 64 ? 2.f : 1.f;
#pragma unroll
          for (int j = 0; j < 8; ++j) {
            const float sft = cf[j] + mul[j] * (pf[j] - cf[j]);
            const float sg = frcp(1.f + __expf(-act_s * sft));
            lv[j] = lseg < 64 ? 2.f * sg - 1.f : (lseg >= 128 ? sg : sft);
          }
          u32x4 w0 = {pack2(lv[0], lv[1]), pack2(lv[2], lv[3]), pack2(lv[4], lv[5]), pack2(lv[6], lv[7])};
          *(u32x4*)(base + (st << 10) + swz(et, c4 + hf)) = w0;
        }
      }
      if (tb + 32 < T) SCAN_LOAD(t0 + 32);
    }
    __syncthreads();
    {
      f32x4 dw = {0.f, 0.f, 0.f, 0.f}, da = dw, dg = dw;
#pragma unroll
      for (int ks = 0; ks < 2; ++ks) {
        bf16x8 aw = *(const bf16x8*)(sTW + (ks << 10) + swz(r, q));
        bf16x8 aa = *(const bf16x8*)(sAL + (ks << 10) + swz(r, q));
        dw = mfma16(aw, bw[ks], dw);
        da = mfma16(aa, ba[ks], da);
      }
#pragma unroll
      for (int ks = 0; ks < 4; ++ks) {
        bf16x8 ag = *(const bf16x8*)(sSG + (ks << 10) + swz(r, q));
        dg = mfma16(ag, bg[ks], dg);
      }
      const int ch = wave * 16 + r;
#pragma unroll
      for (int jj = 0; jj < 4; ++jj) {
        const int tk = q * 4 + jj;
        float z = -(w0c + dw[jj]);
        float sp = z > 20.f ? z : __logf(1.f + __expf(z));
        float logw = -sp - 0.5f;
        sW[tk * 64 + ch] = __expf(-__expf(logw));
        sKKA[tk * 64 + ch] = sigmoidf_(a0c + da[jj]);
        sG[tk * 64 + ch] = dg[jj];
      }
    }
    __syncthreads();
    {
      float kkw[4], kaw[4], rkw[4];
      {
        const float4 a4 = *(const float4*)(p.in[19] + hc), b4 = *(const float4*)(p.in[20] + hc), c4v = *(const float4*)(p.in[21] + hc);
        kkw[0] = a4.x; kkw[1] = a4.y; kkw[2] = a4.z; kkw[3] = a4.w;
        kaw[0] = b4.x; kaw[1] = b4.y; kaw[2] = b4.z; kaw[3] = b4.w;
        rkw[0] = c4v.x; rkw[1] = c4v.y; rkw[2] = c4v.z; rkw[3] = c4v.w;
      }
      float4 k4 = *(const float4*)(sKp + et * 64 + ec);
      float4 a4 = *(const float4*)(sKKA + et * 64 + ec);
      float4 r4 = *(const float4*)(sR + et * 64 + ec);
      float kr[4] = {k4.x, k4.y, k4.z, k4.w}, aa[4] = {a4.x, a4.y, a4.z, a4.w}, rr[4] = {r4.x, r4.y, r4.z, r4.w};
      float kk[4], ss = 0.f;
#pragma unroll
      for (int j = 0; j < 4; ++j) { kk[j] = kr[j] * kkw[j]; ss += kk[j] * kk[j]; }
      ss = row16_sum(ss);
      const float inv = fminf(__builtin_amdgcn_rsqf(ss), 1e12f);
      float kp[4], nk[4], ka[4], rk = 0.f;
#pragma unroll
      for (int j = 0; j < 4; ++j) {
        kk[j] *= inv;
        kp[j] = kr[j] * (1.f + (aa[j] - 1.f) * kaw[j]);
        nk[j] = -kk[j]; ka[j] = kk[j] * aa[j];
        rk += rr[j] * kp[j] * rkw[j];
      }
      rk = row16_sum(rk);
      *(float4*)(sKp + et * 64 + ec) = make_float4(kp[0], kp[1], kp[2], kp[3]);
      *(float4*)(sNKK + et * 64 + ec) = make_float4(nk[0], nk[1], nk[2], nk[3]);
      *(float4*)(sKKA + et * 64 + ec) = make_float4(ka[0], ka[1], ka[2], ka[3]);
      if ((tid & 15) == 0) sRK[et] = rk;
    }
    __syncthreads();
    {
      const int k = tid & 63, tq = tid >> 6;
      float gam = 1.f;
      {
        float wv[12];
#pragma unroll
        for (int t = 0; t < 12; ++t) wv[t] = sW[t * 64 + k];
#pragma unroll
        for (int t = 0; t < 12; ++t) gam *= (t < 4 * tq) ? wv[t] : 1.f;
      }
      float bt[4], kt[4];
#pragma unroll
      for (int i = 0; i < 4; ++i) {
        const int t = 4 * tq + i;
        const float gprev = gam;
        gam *= sW[t * 64 + k];
        const float ginv = frcp(gam);
        const float av = sNKK[t * 64 + k] * gprev;
        const float rv = sR[t * 64 + k] * gam;
        bt[i] = sKKA[t * 64 + k] * ginv;
        kt[i] = sKp[t * 64 + k] * ginv;
        *(u16*)(imgA + t * 144 + k * 2) = f2bf(av);
        *(u16*)(imgR + t * 144 + k * 2) = f2bf(rv);
        *(u16*)(imgB + t * 144 + k * 2) = f2bf(bt[i]);
        *(u16*)(imgK + t * 144 + k * 2) = f2bf(kt[i]);
      }
      u32x2 bv = {pack2(bt[0], bt[1]), pack2(bt[2], bt[3])};
      u32x2 kv = {pack2(kt[0], kt[1]), pack2(kt[2], kt[3])};
      *(u32x2*)(sBKT + k * 72 + tq * 8) = bv;
      *(u32x2*)(sBKT + k * 72 + 32 + tq * 8) = kv;
      if (tq == 3) sGam[k] = gam;
    }
    __syncthreads();
    {
      const unsigned char* Limg = (wave & 1) ? imgK : imgB;
      const unsigned char* Rimg = (wave & 2) ? imgR : imgA;
      f32x4 d = {0.f, 0.f, 0.f, 0.f};
#pragma unroll
      for (int ks = 0; ks < 2; ++ks) {
        bf16x8 lf = *(const bf16x8*)(Limg + r * 144 + ks * 64 + q * 16);
        bf16x8 rf = *(const bf16x8*)(Rimg + r * 144 + ks * 64 + q * 16);
        d = mfma16(lf, rf, d);
      }
      float x[4];
#pragma unroll
      for (int jj = 0; jj < 4; ++jj) {
        const int i = 4 * q + jj;
        const bool keep = (wave & 2) ? (i <= r) : (i < r);
        x[jj] = keep ? d[jj] : 0.f;
      }
      u32x2 xv = {pack2(x[0], x[1]), pack2(x[2], x[3])};
      *(u32x2*)(sMAT + wave * 640 + r * 40 + q * 8) = xv;
      if (wave == 0) {
#pragma unroll
        for (int jj = 0; jj < 4; ++jj) sNab[(4 * q + jj) * 16 + r] = x[jj];
      }
    }
    if (wave == 0) {
      float c[16];
#pragma unroll
      for (int i = 0; i < 16; ++i) c[i] = (i == r) ? 1.f : 0.f;
      int dep = 0;
#pragma unroll
      for (int ig = 14; ig >= 0; ig -= 2) {
        const float* nb = sNab + dep;
#pragma unroll
        for (int i = ig; i > ig - 2 && i >= 0; --i) {
          float acc0 = c[i], acc1 = 0.f;
#pragma unroll
          for (int j = i + 1; j < 16; ++j) { if ((j - i) & 1) acc0 += nb[i * 16 + j] * c[j]; else acc1 += nb[i * 16 + j] * c[j]; }
          c[i] = acc0 + acc1;
        }
        asm volatile("v_mov_b32 %0, 0" : "=v"(dep) : "v"(c[ig > 0 ? ig - 1 : 0]));
      }
      float tc[4];
      const float qm0 = q == 0 ? 1.f : 0.f, qm1 = q == 1 ? 1.f : 0.f, qm2 = q == 2 ? 1.f : 0.f, qm3 = q == 3 ? 1.f : 0.f;
#pragma unroll
      for (int e = 0; e < 4; ++e) tc[e] = qm0 * c[e] + qm1 * c[4 + e] + qm2 * c[8 + e] + qm3 * c[12 + e];
      { u32x2 tv = {pack2(tc[0], tc[1]), pack2(tc[2], tc[3])}; *(u32x2*)(sTT + r * 40 + q * 8) = tv; }
    }
    __syncthreads();
    if (hf == 0) {
#pragma unroll 1
      for (int cc = 0; cc < 2; ++cc) {
        if (cc == 1 && tb + 16 >= T) break;
        unsigned char* rb = smem0 + cc * 61440;
        const unsigned char* c_imgA = rb + 41216;
        const unsigned char* c_imgR = rb + 43520;
        const unsigned char* c_BKT = rb + 50432;
        const unsigned char* c_MAT = rb + 55040;
        const float* c_Gam = (const float*)(rb + 58624);
        const unsigned char* c_TT = rb + 58880;
        const float* c_V = (const float*)(rb + 20480);
        float* c_Y = (float*)(rb + 28672);
        u32x4 w;
        bf16x8 sfr[2];
#pragma unroll
        for (int ks = 0; ks < 2; ++ks) {
          w = (u32x4){pack2(S[2 * ks][0], S[2 * ks][1]), pack2(S[2 * ks][2], S[2 * ks][3]),
                      pack2(S[2 * ks + 1][0], S[2 * ks + 1][1]), pack2(S[2 * ks + 1][2], S[2 * ks + 1][3])};
          sfr[ks] = __builtin_bit_cast(bf16x8, w);
        }
        float vv[4];
#pragma unroll
        for (int e = 0; e < 4; ++e) vv[e] = c_V[(4 * q + e) * 64 + vme];
        const u32x2 vpk = {pack2(vv[0], vv[1]), pack2(vv[2], vv[3])};
        f32x4 rhs = {0.f, 0.f, 0.f, 0.f};
#pragma unroll
        for (int ks = 0; ks < 2; ++ks) {
          u32x2 lo = *(const u32x2*)(c_imgA + r * 144 + (32 * ks + 4 * q) * 2);
          u32x2 hi = *(const u32x2*)(c_imgA + r * 144 + (32 * ks + 16 + 4 * q) * 2);
          w = (u32x4){lo[0], lo[1], hi[0], hi[1]};
          rhs = mfma16(__builtin_bit_cast(bf16x8, w), sfr[ks], rhs);
        }
        {
          u32x2 nk = *(const u32x2*)(c_MAT + 1 * 640 + r * 40 + q * 8);
          w = (u32x4){nk[0], nk[1], 0u, 0u};
          u32x4 wb = {vpk[0], vpk[1], 0u, 0u};
          rhs = mfma16(__builtin_bit_cast(bf16x8, w), __builtin_bit_cast(bf16x8, wb), rhs);
        }
        f32x4 ut = {0.f, 0.f, 0.f, 0.f};
        {
          u32x2 tv = *(const u32x2*)(c_TT + r * 40 + q * 8);
          w = (u32x4){tv[0], tv[1], 0u, 0u};
          u32x4 wb = {pack2(rhs[0], rhs[1]), pack2(rhs[2], rhs[3]), 0u, 0u};
          ut = mfma16(__builtin_bit_cast(bf16x8, w), __builtin_bit_cast(bf16x8, wb), ut);
        }
        const u32x4 uvb = {pack2(ut[0], ut[1]), pack2(ut[2], ut[3]), vpk[0], vpk[1]};
        const bf16x8 uvf = __builtin_bit_cast(bf16x8, uvb);
        f32x4 yt = {0.f, 0.f, 0.f, 0.f};
#pragma unroll
        for (int ks = 0; ks < 2; ++ks) {
          u32x2 lo = *(const u32x2*)(c_imgR + r * 144 + (32 * ks + 4 * q) * 2);
          u32x2 hi = *(const u32x2*)(c_imgR + r * 144 + (32 * ks + 16 + 4 * q) * 2);
          w = (u32x4){lo[0], lo[1], hi[0], hi[1]};
          yt = mfma16(__builtin_bit_cast(bf16x8, w), sfr[ks], yt);
        }
        {
          u32x2 mb = *(const u32x2*)(c_MAT + 2 * 640 + r * 40 + q * 8);
          u32x2 mk = *(const u32x2*)(c_MAT + 3 * 640 + r * 40 + q * 8);
          w = (u32x4){mb[0], mb[1], mk[0], mk[1]};
          yt = mfma16(__builtin_bit_cast(bf16x8, w), uvf, yt);
        }
#pragma unroll
        for (int jj = 0; jj < 4; ++jj) c_Y[(4 * q + jj) * 64 + vme] = yt[jj];
#pragma unroll
        for (int g = 0; g < 4; ++g) {
          u32x2 bb = *(const u32x2*)(c_BKT + (16 * g + r) * 72 + q * 8);
          u32x2 kb = *(const u32x2*)(c_BKT + (16 * g + r) * 72 + 32 + q * 8);
          w = (u32x4){bb[0], bb[1], kb[0], kb[1]};
          f32x4 ds = {0.f, 0.f, 0.f, 0.f};
          ds = mfma16(__builtin_bit_cast(bf16x8, w), uvf, ds);
          const float4 gm = *(const float4*)(c_Gam + 16 * g + 4 * q);
          S[g][0] = (S[g][0] + ds[0]) * gm.x; S[g][1] = (S[g][1] + ds[1]) * gm.y;
          S[g][2] = (S[g][2] + ds[2]) * gm.z; S[g][3] = (S[g][3] + ds[3]) * gm.w;
        }
      }
    }
    __syncthreads();
    {
      float lnw[4], lnb[4];
      {
        const float4 a4 = *(const float4*)(p.in[22] + hc), b4 = *(const float4*)(p.in[23] + hc);
        lnw[0] = a4.x; lnw[1] = a4.y; lnw[2] = a4.z; lnw[3] = a4.w;
        lnb[0] = b4.x; lnb[1] = b4.y; lnb[2] = b4.z; lnb[3] = b4.w;
      }
      float4 y4 = *(const float4*)(sY + et * 64 + ec);
      float yy[4] = {y4.x, y4.y, y4.z, y4.w};
      float s1 = row16_sum(yy[0] + yy[1] + yy[2] + yy[3]);
      const float mean = s1 * (1.f / 64.f);
      float s2 = 0.f;
#pragma unroll
      for (int j = 0; j < 4; ++j) { yy[j] -= mean; s2 += yy[j] * yy[j]; }
      s2 = row16_sum(s2);
      const float rs = __builtin_amdgcn_rsqf(s2 * (1.f / 64.f) + 64e-5f);
      const float rk = sRK[et];
      float4 v4 = *(const float4*)(sV + et * 64 + ec);
      float4 g4 = *(const float4*)(sG + et * 64 + ec);
      const float vv[4] = {v4.x, v4.y, v4.z, v4.w}, gg[4] = {g4.x, g4.y, g4.z, g4.w};
      float o[4];
#pragma unroll
      for (int j = 0; j < 4; ++j) o[j] = (yy[j] * rs * lnw[j] + lnb[j] + rk * vv[j]) * gg[j];
      u32x2 ov = {pack2(o[0], o[1]), pack2(o[2], o[3])};
      if (t0 < T) *(u32x2*)(MIX + (size_t)(row0 + t0 + et) * 1024 + hc) = ov;
    }
    __syncthreads();
  }
  if (hf == 0) {
    float* so = is_p ? p.out + O_WKVP + ((size_t)stream * 8 + h) * 4096 : p.out + O_WKVS + ((size_t)(stream - 16) * 8 + h) * 4096;
#pragma unroll
    for (int g = 0; g < 4; ++g) *(float4*)(so + vme * 64 + g * 16 + q * 4) = make_float4(S[g][0], S[g][1], S[g][2], S[g][3]);
  }
}

__device__ __forceinline__ void phase_mix(const Params& p, unsigned char* smem, int qslot) {
  __shared__ int s_item;
  int* counter = (int*)(p.ws + WS_ZERO) + qslot;
  const int N_SCANP = 128, N_ATTS = 64, N_ATTP = 2048, N_SCANS = 64, N_ATTM = 128;
  const int total = N_SCANP + N_ATTS + N_ATTP + N_SCANS + N_ATTM;
  const u16* Q = (const u16*)(p.ws + WS_Q);
  const u16* KALL = (const u16*)(p.ws + WS_KALL);
  u16* MIX = (u16*)(p.ws + WS_MIX);
  while (true) {
    __syncthreads();
    if (threadIdx.x == 0) s_item = atomicAdd(counter, 1);
    __syncthreads();
    int it = s_item;
    if (it >= total) break;
    bool is_scan = false; int sc_stream = 0, sc_h = 0;
    AttnItem a{};
    if (it < N_SCANP) { is_scan = true; sc_stream = it >> 3; sc_h = it & 7; }
    else if (it < N_SCANP + N_ATTS) {
      it -= N_SCANP;
      const int bd = it >> 3, h = it & 7;
      a.Q = Q + (size_t)(M_P + bd * 64) * 768 + h * 96;
      a.Kb = KALL + (size_t)(M_TOT + bd * KS_S) * 768 + h * 96;
      a.Vt = (const u16*)(p.ws + WS_VTS) + ((size_t)bd * 512 + h * 64) * TPAD_S; a.ldv = TPAD_S;
      a.O = MIX + (size_t)(M_P + bd * 64) * 1024 + 512 + h * 64;
      a.nq_valid = 64; a.ntiles = 33; a.wt_base = 33; a.wt_step = 0;
    } else if (it < N_SCANP + N_ATTS + N_ATTP) {
      it -= N_SCANP + N_ATTS;
      const int j = 15 - (it >> 7), bh = it & 127, b = bh >> 3, h = bh & 7;
      const size_t qrow = (size_t)b * TP + 16 + 256 * j;
      a.Q = Q + qrow * 768 + h * 96;
      a.Kb = KALL + (size_t)b * TP * 768 + h * 96;
      a.Vt = (const u16*)(p.ws + WS_VTP) + ((size_t)b * 512 + h * 64) * TPAD_P; a.ldv = TPAD_P;
      a.O = MIX + qrow * 1024 + 512 + h * 64;
      a.nq_valid = 256; a.ntiles = 4 * j + 4; a.wt_base = 4 * j + 1; a.wt_step = 1;
    } else if (it < N_SCANP + N_ATTS + N_ATTP + N_SCANS) {
      it -= N_SCANP + N_ATTS + N_ATTP;
      is_scan = true; sc_stream = 16 + (it >> 3); sc_h = it & 7;
    } else {
      it -= N_SCANP + N_ATTS + N_ATTP + N_SCANS;
      const int b = it >> 3, h = it & 7;
      const size_t qrow = (size_t)b * TP;
      a.Q = Q + qrow * 768 + h * 96;
      a.Kb = KALL + (size_t)b * TP * 768 + h * 96;
      a.Vt = (const u16*)(p.ws + WS_VTP) + ((size_t)b * 512 + h * 64) * TPAD_P; a.ldv = TPAD_P;
      a.O = MIX + qrow * 1024 + 512 + h * 64;
      a.nq_valid = 16; a.ntiles = 0; a.wt_base = 0; a.wt_step = 0;
    }
    if (is_scan) scan_item(p, sc_stream, sc_h, smem);
    else attn_item(a, smem);
  }
}

__device__ __forceinline__ void phase_final(const Params& p) {
  const float* ssq4 = (const float*)(p.ws + WS_ZERO + 256) + 3 * (size_t)M_TOT;
  const float* gf = p.in[34];
  const int lane = threadIdx.x & 63, wave = threadIdx.x >> 6;
  const int rstride = gridDim.x * NWAVES;
  for (int orow0 = blockIdx.x * NWAVES + wave; orow0 < 65536 + 512; orow0 += 2 * rstride) {
    float* y[2]; const u16* xrow[2]; float rs[2]; bool ok[2];
#pragma unroll
    for (int u = 0; u < 2; ++u) {
      int orow = orow0 + u * rstride; ok[u] = orow < 65536 + 512; if (!ok[u]) orow = orow0;
      int row;
      if (orow < 65536) { int b = orow >> 12, f = orow & 4095; row = b * TP + 16 + f; y[u] = p.out + O_YP + (size_t)orow * 1024; }
      else { row = M_P + (orow - 65536); y[u] = p.out + O_YS + (size_t)(orow - 65536) * 1024; }
      rs[u] = rsqrtf(ssq4[row] * (1.f / 1024.f) + 1e-6f);
      xrow[u] = (const u16*)(p.ws + WS_XB) + (size_t)row * D;
    }
    u32x2 v[2][4];
#pragma unroll
    for (int u = 0; u < 2; ++u)
#pragma unroll
      for (int i = 0; i < 4; ++i) v[u][i] = *(const u32x2*)(xrow[u] + i * 256 + lane * 4);
#pragma unroll
    for (int u = 0; u < 2; ++u)
#pragma unroll
      for (int i = 0; i < 4; ++i) {
        const float4 g = *(const float4*)(gf + i * 256 + lane * 4);
        float4 t;
        t.x = bflo(v[u][i][0]) * rs[u] * g.x; t.y = bfhi(v[u][i][0]) * rs[u] * g.y;
        t.z = bflo(v[u][i][1]) * rs[u] * g.z; t.w = bfhi(v[u][i][1]) * rs[u] * g.w;
        if (ok[u]) *(float4*)(y[u] + i * 256 + lane * 4) = t;
      }
  }
}

__device__ __forceinline__ void run_phase(const Params& p, int ph, unsigned char* smem, int qslot, const XcdInfo xi) {
  float* ssq = (float*)(p.ws + WS_ZERO + 256);
  u16* XB = (u16*)(p.ws + WS_XB);
  u16* ACT = (u16*)(p.ws + WS_ACT);
  switch (ph) {
#if PH_ON(0)
    case 0: phase_prep(p, smem); break;
#endif
#if PH_ON(1)
    case 1: {
      GemmArgs g{XB, D, (const u16*)(p.ws + WS_W13A), D, D};
      EpiArgs e{}; e.ssq_in = ssq; e.dst = ACT; e.ldd = DFF;
      gemm_phase<EPI_FFNUP, 8>(g, e, 256, 22, smem, xi, NCH_UP);
      gemm_phase<EPI_FFNUP, 4>(g, e, 6, 22, smem, xi, NCH_UP, 65536);
    } break;
#endif
#if PH_ON(2)
    case 2: {
      GemmArgs g{ACT, DFF, (const u16*)(p.ws + WS_W2A), DFF, DFF};
      EpiArgs e{}; e.ssq_out = ssq + M_TOT; e.dst = XB; e.ldd = D; e.alpha = 0.5f;
      gemm_phase<EPI_RESID, 8>(g, e, 256, 4, smem, xi, NCH_DOWN);
      gemm_phase<EPI_RESID, 4>(g, e, 6, 4, smem, xi, NCH_DOWN, 65536);
    } break;
#endif
#if PH_ON(3)
    case 3: {
      GemmArgs g{XB, D, (const u16*)(p.ws + WS_WIN), D, D};
      EpiArgs e{}; e.ssq_in = ssq + M_TOT; e.dst = (u16*)(p.ws + WS_P); e.ldd = NIN; e.out = p.out;
      gemm_phase<EPI_WIN, 8>(g, e, 256, 9, smem, xi, NCH_WIN);
      gemm_phase<EPI_WIN, 4>(g, e, 6, 9, smem, xi, NCH_WIN, 65536);
    } break;
#endif
#if PH_ON(4)
    case 4: phase_mla_prep(p); break;
#endif
#if PH_ON(5)
    case 5: phase_mla_gemms(p, smem); break;
#endif
#if PH_ON(6)
    case 6: phase_mix(p, smem, qslot); break;
#endif
#if PH_ON(7)
    case 7: {
      GemmArgs g{(const u16*)(p.ws + WS_MIX), D, (const u16*)(p.ws + WS_WOUT), D, D};
      EpiArgs e{}; e.ssq_out = ssq + 2 * (size_t)M_TOT; e.dst = XB; e.ldd = D; e.alpha = 1.f;
      gemm_phase<EPI_RESID, 8>(g, e, 256, 4, smem, xi, NCH_OUT);
      gemm_phase<EPI_RESID, 4>(g, e, 6, 4, smem, xi, NCH_OUT, 65536);
    } break;
#endif
#if PH_ON(8)
    case 8: {
      GemmArgs g{XB, D, (const u16*)(p.ws + WS_W13B), D, D};
      EpiArgs e{}; e.ssq_in = ssq + 2 * (size_t)M_TOT; e.dst = ACT; e.ldd = DFF;
      gemm_phase<EPI_FFNUP, 8>(g, e, 256, 22, smem, xi, NCH_UP);
      gemm_phase<EPI_FFNUP, 4>(g, e, 6, 22, smem, xi, NCH_UP, 65536);
    } break;
#endif
#if PH_ON(9)
    case 9: {
      GemmArgs g{ACT, DFF, (const u16*)(p.ws + WS_W2B), DFF, DFF};
      EpiArgs e{}; e.ssq_out = ssq + 3 * (size_t)M_TOT; e.dst = XB; e.ldd = D; e.alpha = 0.5f; e.out = p.out;
      gemm_phase<EPI_RESID, 8>(g, e, 256, 4, smem, xi, NCH_DOWN);
      gemm_phase<EPI_RESID, 4>(g, e, 6, 4, smem, xi, NCH_DOWN, 65536);
    } break;
#endif
#if PH_ON(10)
    case 10: phase_final(p); break;
#endif
  }
}


#define XB_TMO      128
#define XB_XCNT(j)  (256  + 64 * (j))
#define XB_XSUB(j)  (1280 + 64 * (j))
#define XB_XGEN(j)  (2304 + 64 * (j))
#define XB_TOP      3328
#define XB_TOPGEN   3392
#define XB_SPIN_CAP (1u << 20)
#define LAS __attribute__((address_space(3)))
__device__ __forceinline__ unsigned xb_ld(unsigned* p)              { return __hip_atomic_load(p, __ATOMIC_RELAXED, __HIP_MEMORY_SCOPE_AGENT); }
__device__ __forceinline__ unsigned xb_add(unsigned* p, unsigned v) { return __hip_atomic_fetch_add(p, v, __ATOMIC_RELAXED, __HIP_MEMORY_SCOPE_AGENT); }
__device__ __forceinline__ unsigned xb_xcc_id() { return (unsigned)__builtin_amdgcn_s_getreg((3 << 11) | 20) & 0xFu; }
#define XB_SPIN(cond, bar) do { unsigned _sp = 0; while (cond) { __builtin_amdgcn_s_sleep(1); \
    if ((++_sp & 255u) == 0u) { if (xb_ld(&(bar)[XB_TMO])) break; if (_sp > XB_SPIN_CAP) { atomicAdd(&(bar)[XB_TMO], 1u); break; } } } } while (0)
struct XcdBarrier { unsigned* bar; unsigned x; volatile LAS unsigned* st; };
__device__ __forceinline__ XcdBarrier xcd_barrier_post(unsigned* bar, volatile LAS unsigned* st) {
    XcdBarrier b; b.bar = bar; b.x = xb_xcc_id(); b.st = st;
    if (threadIdx.x == 0) (void)xb_add(&bar[XB_XCNT(b.x)], 1u);
    return b;
}
__device__ __forceinline__ void xcd_barrier_complete(unsigned* bar, unsigned x, unsigned& nloc, unsigned& nx) {
    const unsigned G = gridDim.x * gridDim.y * gridDim.z;
    unsigned sum, cnt, mine, sp = 0u;
    for (;;) {
        sum = 0u; cnt = 0u; mine = 0u;
#pragma unroll
        for (unsigned j = 0; j < 16; ++j) { const unsigned c = xb_ld(&bar[XB_XCNT(j)]); sum += c; cnt += (c > 0u) ? 1u : 0u; mine = (j == x) ? c : mine; }
        if (sum == G) break;
        __builtin_amdgcn_s_sleep(1);
        if ((++sp & 255u) == 0u) { if (xb_ld(&bar[XB_TMO])) break; if (sp > XB_SPIN_CAP) { atomicAdd(&bar[XB_TMO], 1u); break; } }
    }
    nloc = mine > 0u ? mine : 1u; nx = cnt > 0u ? cnt : 1u;
}
__device__ __forceinline__ void xcd_barrier(const XcdBarrier& b) {
    asm volatile("s_waitcnt vmcnt(0)" ::: "memory");
    __syncthreads();
    if (threadIdx.x == 0) {
        unsigned* bar = b.bar;
        __builtin_amdgcn_s_waitcnt(0);
        unsigned nloc = b.st[0], nx = b.st[1];
        if (nloc == 0u) { xcd_barrier_complete(bar, b.x, nloc, nx); b.st[0] = nloc; b.st[1] = nx; }
        const unsigned old = xb_add(&bar[XB_XSUB(b.x)], 1u);
        const unsigned gen = old / nloc;
        if (old + 1u == (gen + 1u) * nloc) {
            __builtin_amdgcn_fence(__ATOMIC_RELEASE, "agent");
            asm volatile("s_waitcnt vmcnt(0)" ::: "memory");
            const unsigned og = xb_add(&bar[XB_TOP], 1u);
            const unsigned tg = og / nx;
            if (og + 1u == (tg + 1u) * nx) xb_add(&bar[XB_TOPGEN], 1u);
            else XB_SPIN(xb_ld(&bar[XB_TOPGEN]) == tg, bar);
            __builtin_amdgcn_fence(__ATOMIC_ACQUIRE, "agent");
            xb_add(&bar[XB_XGEN(b.x)], 1u);
            asm volatile("s_waitcnt vmcnt(0)" ::: "memory");
        } else {
            XB_SPIN(xb_ld(&bar[XB_XGEN(b.x)]) == gen, bar);
            __builtin_amdgcn_fence(__ATOMIC_ACQUIRE, "agent");
            asm volatile("s_waitcnt vmcnt(0)" ::: "memory");
        }
    }
    __syncthreads();
}

__global__ void __launch_bounds__(NTHREADS, 2) mega(Params p, int ph_lo, int ph_hi) {
  __shared__ __attribute__((aligned(16))) unsigned char smem[SMEM_BYTES];
  cg::grid_group grid = cg::this_grid();
  __shared__ int s_xi[2];
  int* xcnt = (int*)(p.ws + WS_ZERO) + 16;
  if (threadIdx.x == 0) {
    const int xcc = __builtin_amdgcn_s_getreg(0x1814) & 7;
    s_xi[0] = xcc;
    s_xi[1] = atomicAdd(xcnt + xcc, 1);
  }
  XcdInfo xi{(int)(blockIdx.x & 7), (int)(blockIdx.x >> 3), (gridDim.x & 7) == 0 ? (int)(gridDim.x >> 3) : 0};
  __shared__ __attribute__((aligned(16))) unsigned xb_words[4];
  if (threadIdx.x == 0) { xb_words[0] = 0u; xb_words[1] = 0u; }
  __syncthreads();
  const XcdBarrier xb = xcd_barrier_post((unsigned*)(p.ws + WS_XBAR), (volatile LAS unsigned*)&xb_words);
#ifndef PROBE_DBL
#define PROBE_DBL 0
#endif
#define RUN_PH(X) if (ph_lo <= X && X <= ph_hi) { if ((PROBE_DBL >> X) & 1) { run_phase(p, X, smem, 1, xi); grid.sync(); } run_phase(p, X, smem, 0, xi); if (X < ph_hi) { if (X == 0) grid.sync(); else xcd_barrier(xb); } }
  RUN_PH(0)
  if (ph_lo == 0 && ph_hi > 0) {
    int c0 = __hip_atomic_load(xcnt, __ATOMIC_RELAXED, __HIP_MEMORY_SCOPE_AGENT);
    bool even = c0 > 0 && c0 * 8 == (int)gridDim.x;
#pragma unroll
    for (int i = 1; i < 8; ++i) even = even && (__hip_atomic_load(xcnt + i, __ATOMIC_RELAXED, __HIP_MEMORY_SCOPE_AGENT) == c0);
    if (even) { xi.xcd = s_xi[0]; xi.slot = s_xi[1]; xi.nbx = c0; }
  }
  RUN_PH(1) RUN_PH(2) RUN_PH(3) RUN_PH(4) RUN_PH(5) RUN_PH(6) RUN_PH(7) RUN_PH(8) RUN_PH(9) RUN_PH(10)
}

extern "C" void kernel_launch(void* const* d_in, const int* in_sizes, int n_in, void* d_out, int out_size,
                              void* d_ws, size_t ws_size, hipStream_t stream) {
  static int grid_blocks = 0;
  if (!grid_blocks) {
    int dev = 0, cus = 0, per_cu = 0;
    hipGetDevice(&dev);
    hipDeviceGetAttribute(&cus, hipDeviceAttributeMultiprocessorCount, dev);
    hipOccupancyMaxActiveBlocksPerMultiprocessor(&per_cu, mega, NTHREADS, 0);
    if (per_cu > 1) per_cu = 1;
    if (per_cu < 1) per_cu = 1;
    grid_blocks = cus * per_cu;
  }
  Params p{};
  for (int i = 0; i < 35; ++i) p.in[i] = (const float*)d_in[i];
  p.out = (float*)d_out;
  p.ws = (unsigned char*)d_ws;
  hipMemsetAsync((unsigned char*)d_ws + WS_ZERO, 0, ZERO_BYTES, stream);
#if ONE_LAUNCH
  int lo = 0, hi = 10;
  void* args[] = {&p, &lo, &hi};
  hipError_t e = hipLaunchCooperativeKernel((void*)mega, dim3(grid_blocks), dim3(NTHREADS), args, 0, stream);
  if (e != hipSuccess) fprintf(stderr, "cooperative launch failed: %s (grid %d)\n", hipGetErrorString(e), grid_blocks);
#else
  for (int ph = 0; ph <= 10; ++ph) {
    int lo = ph, hi = ph;
    void* args[] = {&p, &lo, &hi};
    hipError_t e = hipLaunchCooperativeKernel((void*)mega, dim3(grid_blocks), dim3(NTHREADS), args, 0, stream);
    if (e != hipSuccess) fprintf(stderr, "cooperative launch failed: %s (grid %d)\n", hipGetErrorString(e), grid_blocks);
  }
#endif
}
```

```cpp
#include <hip/hip_runtime.h>
#include <hip/hip_cooperative_groups.h>
#include <cstdio>
#include <type_traits>
namespace cg = cooperative_groups;

typedef unsigned short u16;
typedef unsigned int u32;
using bf16x8 = __attribute__((ext_vector_type(8))) short;
using f32x4 = __attribute__((ext_vector_type(4))) float;
using u32x4 = __attribute__((ext_vector_type(4))) unsigned;
using u32x2 = __attribute__((ext_vector_type(2))) unsigned;
#define DI __device__ __forceinline__

#ifndef PHASE_MASK
#define PHASE_MASK 0x7ff
#endif
#define PH_ON(x) ((PHASE_MASK >> (x)) & 1)
#ifndef NCH_UP
#define NCH_UP 4
#endif
#ifndef NCH_DOWN
#define NCH_DOWN 0
#endif
#ifndef NCH_WIN
#define NCH_WIN 2
#endif
#ifndef NCH_OUT
#define NCH_OUT 0
#endif
#ifndef RES_MF
#define RES_MF 8
#endif
#ifndef ONE_LAUNCH
#define ONE_LAUNCH 1
#endif

constexpr int D = 1024;
constexpr int TP = 4112;
constexpr int M_P = 16 * TP;
constexpr int M_TOT = M_P + 512;
constexpr int DFF = 2816;
constexpr int NIN = 2208;
constexpr int NINP = 2304;
constexpr int KS_S = 2128;
constexpr int KS_TOT = M_TOT + 8 * KS_S;
constexpr int KS_ALLOC = 326 * 256 + 256;
constexpr int TPAD_P = 4352;
constexpr int TPAD_S = 2304;
constexpr int NTHREADS = 512;
constexpr int NWAVES = 8;

constexpr long O_YP = 0;
constexpr long O_YS = O_YP + 16L * 4096 * 1024;
constexpr long O_CKVP = O_YS + 8L * 64 * 1024;
constexpr long O_KRP = O_CKVP + 16L * TP * 128;
constexpr long O_WKVP = O_KRP + 16L * TP * 32;
constexpr long O_SHP = O_WKVP + 16L * 8 * 64 * 64;
constexpr long O_CKVS = O_SHP + 16L * 1792;
constexpr long O_KRS = O_CKVS + 8L * 64 * 128;
constexpr long O_WKVS = O_KRS + 8L * 64 * 32;
constexpr long O_SHS = O_WKVS + 8L * 8 * 64 * 64;

constexpr size_t al256(size_t x) { return (x + 255) & ~size_t(255); }
constexpr size_t WS_ZERO = 0;
constexpr size_t WS_XBAR = WS_ZERO + 256 + 4 * (size_t)M_TOT * 4;
constexpr size_t ZERO_BYTES = al256(256 + 4 * (size_t)M_TOT * 4 + 3456 * 4);
constexpr size_t WS_ROPE = WS_ZERO + ZERO_BYTES;
constexpr size_t WS_W13A = WS_ROPE + al256((size_t)TP * 16 * 8);
constexpr size_t WS_W2A = WS_W13A + (size_t)2 * DFF * D * 2;
constexpr size_t WS_WIN = WS_W2A + (size_t)D * DFF * 2;
constexpr size_t WS_WOUT = WS_WIN + (size_t)NINP * D * 2;
constexpr size_t WS_W13B = WS_WOUT + (size_t)D * D * 2;
constexpr size_t WS_W2B = WS_W13B + (size_t)2 * DFF * D * 2;
constexpr size_t WS_WQ = WS_W2B + (size_t)D * DFF * 2;
constexpr size_t WS_WUK = WS_WQ + (size_t)768 * 256 * 2;
constexpr size_t WS_WUV = WS_WUK + (size_t)512 * 128 * 2;
constexpr size_t WS_WW2 = WS_WUV + (size_t)512 * 128 * 2;
constexpr size_t WS_WA2 = WS_WW2 + (size_t)512 * 64 * 2;
constexpr size_t WS_WG2 = WS_WA2 + (size_t)512 * 64 * 2;
constexpr size_t WS_XB = al256(WS_WG2 + (size_t)512 * 128 * 2);
constexpr size_t WS_ACT = WS_XB + (size_t)M_TOT * D * 2;
constexpr size_t ACT_BYTES = (size_t)M_TOT * DFF * 2;
constexpr size_t WS_P = WS_ACT + ACT_BYTES;
constexpr size_t WS_MIX = WS_P + al256((size_t)M_TOT * NIN * 2);
constexpr size_t WS_CQN = WS_MIX + (size_t)M_TOT * D * 2;
constexpr size_t WS_CB = WS_CQN + (size_t)M_TOT * 256 * 2;
constexpr size_t WS_END = WS_CB + (size_t)KS_ALLOC * 128 * 2;
constexpr size_t WS_Q = WS_ACT;
constexpr size_t WS_KALL = WS_Q + (size_t)M_TOT * 768 * 2;
constexpr size_t WS_VTP = WS_KALL + (size_t)KS_ALLOC * 768 * 2;
constexpr size_t WS_VTS = WS_VTP + (size_t)16 * 512 * TPAD_P * 2;
constexpr size_t WS_ALIAS_END = WS_VTS + (size_t)8 * 512 * TPAD_S * 2;
static_assert(WS_ALIAS_END <= WS_ACT + ACT_BYTES, "alias region overflow");
static_assert(WS_END <= (size_t)1 << 30, "workspace too large");

constexpr int SMEM_BYTES = 131072;

struct Params {
  const float* in[35];
  float* out;
  unsigned char* ws;
};

DI u32 pack2(float a, float b);
DI u16 f2bf(float f) { return (u16)(pack2(f, 0.f) & 0xffffu); }
DI float bf2f(u16 h) { return __uint_as_float(((u32)h) << 16); }
typedef float f32x2_t __attribute__((ext_vector_type(2)));
typedef __bf16 bf16x2_t __attribute__((ext_vector_type(2)));
DI u32 pack2(float a, float b) {
  f32x2_t v = {a, b};
  bf16x2_t r = __builtin_convertvector(v, bf16x2_t);
  return __builtin_bit_cast(u32, r);
}
DI float bflo(u32 v) { return __uint_as_float(v << 16); }
DI float bfhi(u32 v) { return __uint_as_float(v & 0xffff0000u); }
DI float wave_sum(float v) {
#pragma unroll
  for (int o = 32; o >= 1; o >>= 1) v += __shfl_xor(v, o);
  return v;
}
template <int CTRL> DI float dpp_f(float v) {
  return __int_as_float(__builtin_amdgcn_update_dpp(0, __float_as_int(v), CTRL, 0xf, 0xf, false));
}
DI float row16_sum(float v) {
  v += dpp_f<0xB1>(v);
  v += dpp_f<0x4E>(v);
  v += dpp_f<0x141>(v);
  v += dpp_f<0x140>(v);
  return v;
}
DI float frcp(float x) { return __builtin_amdgcn_rcpf(x); }
DI float sigmoidf_(float x) { return frcp(1.f + __expf(-x)); }
DI float siluf_(float x) { return x * frcp(1.f + __expf(-x)); }
DI int row_pos(int row) { return row < M_P ? row % TP : 2064 + ((row - M_P) & 63); }
DI int swz(int r, int c4) { return r * 64 + ((c4 ^ ((r >> 3) << 1)) << 4); }
DI f32x4 mfma16(bf16x8 a, bf16x8 b, f32x4 c) { return __builtin_amdgcn_mfma_f32_16x16x32_bf16(a, b, c, 0, 0, 0); }

struct TJob { const float* src; int K, N, Npad; size_t dst; const float* gain; float scale; int mode; };
DI void transpose_tile(const Params& p, const TJob& j, int kt, int nt, float* sm, bool active) {
  const float* src = j.src;
  const float* gain = j.gain;
  u16* dst = (u16*)(p.ws + j.dst);
  const int tid = threadIdx.x & 255;
  sm += (threadIdx.x >> 8) * (64 * 65);
  __syncthreads();
  if (active) {
#pragma unroll
  for (int i = 0; i < 16; ++i) {
    int idx = tid + i * 256;
    int kk = idx >> 6, nn = idx & 63;
    int k = kt * 64 + kk, n = nt * 64 + nn;
    float v = 0.f;
    if (n < j.N) {
      v = src[(size_t)k * j.N + n] * j.scale;
      if (gain) v *= gain[k];
    }
    sm[kk * 65 + nn] = v;
  }
  }
  __syncthreads();
  if (active) {
    int nn = tid >> 2, kq = (tid & 3) * 16;
    int n = nt * 64 + nn;
    int drow = n;
    if (j.mode == 3) {
      const int c = n & 63;
      drow = (n & ~63) + 16 * ((c & 15) >> 2) + 4 * (c >> 4) + (c & 3);
    } else if (j.mode) {
      const int a = n & 31;
      drow = ((n >> 5) << 6) + ((((a & 7) >> 2) * 2 + (j.mode == 2 ? 1 : 0)) << 4) + 4 * (a >> 3) + (a & 3);
    }
    u32 w[8];
#pragma unroll
    for (int i = 0; i < 8; ++i) w[i] = pack2(sm[(kq + 2 * i) * 65 + nn], sm[(kq + 2 * i + 1) * 65 + nn]);
    u32x4* d = (u32x4*)(dst + (size_t)drow * j.K + kt * 64 + kq);
    u32x4 a = {w[0], w[1], w[2], w[3]}, b = {w[4], w[5], w[6], w[7]};
    d[0] = a; d[1] = b;
  }
}

__device__ __forceinline__ void phase_prep(const Params& p, unsigned char* smem) {
  float* sm = (float*)smem;
  const float qs = 0.10206207261596577f * 1.4426950408889634f;
  auto get_job = [&](int ji) -> TJob {
    switch (ji) {
      case 0: return TJob{p.in[8], D, DFF, DFF, WS_W13A, p.in[7], 1.f, 1};
      case 1: return TJob{p.in[9], D, DFF, DFF, WS_W13A, p.in[7], 1.f, 2};
      case 2: return TJob{p.in[10], DFF, D, D, WS_W2A, nullptr, 1.f, 3};
      case 3: return TJob{p.in[12], D, NIN, NINP, WS_WIN, p.in[11], 1.f, 3};
      case 4: return TJob{p.in[29], D, D, D, WS_WOUT, nullptr, 1.f, 3};
      case 5: return TJob{p.in[31], D, DFF, DFF, WS_W13B, p.in[30], 1.f, 1};
      case 6: return TJob{p.in[32], D, DFF, DFF, WS_W13B, p.in[30], 1.f, 2};
      case 7: return TJob{p.in[33], DFF, D, D, WS_W2B, nullptr, 1.f, 3};
      case 8: return TJob{p.in[25], 256, 768, 768, WS_WQ, p.in[24], qs, 0};
      case 9: return TJob{p.in[27], 128, 512, 512, WS_WUK, nullptr, 1.f, 3};
      case 10: return TJob{p.in[28], 128, 512, 512, WS_WUV, nullptr, 1.f, 0};
      case 11: return TJob{p.in[15], 64, 512, 512, WS_WW2, nullptr, 1.f, 0};
      case 12: return TJob{p.in[17], 64, 512, 512, WS_WA2, nullptr, 1.f, 0};
      default: return TJob{p.in[18], 128, 512, 512, WS_WG2, nullptr, 1.f, 0};
    }
  };
  int base = 0;
#pragma unroll 1
  for (int ji = 0; ji < 14; ++ji) {
    const TJob j = get_job(ji);
    int nkt = j.K / 64, nnt = j.Npad / 64;
    int cnt = nkt * nnt;
    int first = ((int)blockIdx.x - base % (int)gridDim.x + (int)gridDim.x) % (int)gridDim.x;
    for (int t = first; t < cnt; t += 2 * gridDim.x) {
      const int tt = t + (int)(threadIdx.x >> 8) * (int)gridDim.x;
      transpose_tile(p, j, tt % nkt, tt / nkt, sm, tt < cnt);
    }
    base += cnt;
  }
  {
    u16* xb = (u16*)(p.ws + WS_XB);
    float* ssq1 = (float*)(p.ws + WS_ZERO + 256);
    const int lane = threadIdx.x & 63, wave = threadIdx.x >> 6;
    const int rstride = gridDim.x * NWAVES;
    for (int row = blockIdx.x * NWAVES + wave; row < M_TOT; row += 2 * rstride) {
      const float* src[2]; int rows[2]; bool ok[2];
#pragma unroll
      for (int u = 0; u < 2; ++u) {
        int rw = row + u * rstride; ok[u] = rw < M_TOT; if (!ok[u]) rw = row; rows[u] = rw;
        if (rw < M_P) {
          int b = rw / TP, pp = rw % TP;
          src[u] = pp < 16 ? p.in[6] + (size_t)pp * D : p.in[0] + ((size_t)b * 4096 + (pp - 16)) * D;
        } else src[u] = p.in[1] + (size_t)(rw - M_P) * D;
      }
      float4 v[2][4];
#pragma unroll
      for (int u = 0; u < 2; ++u)
#pragma unroll
        for (int i = 0; i < 4; ++i) v[u][i] = *(const float4*)(src[u] + i * 256 + lane * 4);
#pragma unroll
      for (int u = 0; u < 2; ++u) {
        float sacc = 0.f;
#pragma unroll
        for (int i = 0; i < 4; ++i) {
          const float4 t = v[u][i];
          sacc += t.x * t.x + t.y * t.y + t.z * t.z + t.w * t.w;
          u32x2 o = {pack2(t.x, t.y), pack2(t.z, t.w)};
          if (ok[u]) *(u32x2*)(xb + (size_t)rows[u] * D + i * 256 + lane * 4) = o;
        }
        sacc = wave_sum(sacc);
        if (lane == 0 && ok[u]) ssq1[rows[u]] = sacc;
      }
    }
  }
  {
    float2* rt = (float2*)(p.ws + WS_ROPE);
    for (int i = blockIdx.x * NTHREADS + threadIdx.x; i < TP * 16; i += gridDim.x * NTHREADS) {
      int pos = i >> 4, f = i & 15;
      float inv = exp2f(-(float)f * (13.287712379549449f / 16.f));
      float ang = (float)pos * inv;
      float rev = ang * 0.15915494309189535f;
      rev = rev - rintf(rev);
      rt[i] = make_float2(__builtin_amdgcn_cosf(rev), __builtin_amdgcn_sinf(rev));
    }
  }
}

struct GemmArgs { const u16* A; long lda; const u16* B; long ldb; int K; };
enum { EPI_FFNUP = 0, EPI_RESID = 1, EPI_WIN = 2, EPI_FINAL = 3, EPI_Q = 4, EPI_KN = 5, EPI_VT = 6 };
struct EpiArgs {
  const float* ssq_in;
  float* ssq_out;
  u16* dst; long ldd;
  float alpha;
  float* out;
  const float2* rope;
  int rows_valid;
};

template <int EPI, int MF>
__device__ __forceinline__ void gemm_tile(const GemmArgs g, const int m0, const int n0, unsigned char* smem, const EpiArgs e,
                                          const bool preloaded = false, const bool has_next = false, const int nm0 = 0, const int nn0 = 0) {
  const int tid = threadIdx.x, lane = tid & 63, wave = tid >> 6;
  const int wm = wave >> 2, wn = wave & 3, r = lane & 15, q = lane >> 4;
  f32x4 acc[MF][4];
#pragma unroll
  for (int m = 0; m < MF; ++m)
#pragma unroll
    for (int n = 0; n < 4; ++n) acc[m][n] = (f32x4){0.f, 0.f, 0.f, 0.f};
  constexpr int APW = MF / 2;
  const int pr = lane >> 3, pc = (lane & 7) ^ (lane >> 3);
  const u16* ag = g.A + (size_t)(m0 + wave * (APW * 8) + pr) * g.lda + pc * 8;
  const u16* bg = g.B + (size_t)(n0 + wave * 32 + pr) * g.ldb + pc * 8;
  const int rr = r & 7;
  const int lbase = ((r >> 3) << 10) + (rr << 7);
  const int lofs0 = lbase + ((q ^ rr) << 4), lofs1 = lbase + (((4 + q) ^ rr) << 4);
  typedef void __attribute__((address_space(3))) * lds_ptr;
  const unsigned lds_base = (unsigned)(unsigned long)((lds_ptr)smem);
  const int nk = g.K >> 6;
  if (!preloaded) __syncthreads();
#define GEMM_PIECE_A(BUF, I) __builtin_amdgcn_global_load_lds((const void*)(ag + (size_t)(I) * 8 * g.lda), (lds_ptr)(smem + (BUF) * 65536 + (wave * APW + (I)) * 1024 + lane * 16), 16, 0, 0)
#define GEMM_PIECE_B(BUF, I) __builtin_amdgcn_global_load_lds((const void*)(bg + (size_t)(I) * 8 * g.ldb), (lds_ptr)(smem + (BUF) * 65536 + 32768 + (wave * 4 + (I)) * 1024 + lane * 16), 16, 0, 0)
#define GEMM_STAGE(BUF)                                                    \
  do {                                                                     \
    _Pragma("unroll") for (int i = 0; i < APW; ++i) GEMM_PIECE_A(BUF, i);  \
    _Pragma("unroll") for (int i = 0; i < 4; ++i) GEMM_PIECE_B(BUF, i);    \
    ag += 64; bg += 64;                                                    \
  } while (0)
#define GEMM_WAIT0 asm volatile("s_waitcnt vmcnt(0)\n\ts_barrier" ::: "memory")
  if (preloaded) { ag += 64; bg += 64; }
  else GEMM_STAGE(0);
  GEMM_WAIT0;
  int buf = 0;
#pragma unroll 1
  for (int kt = 0; kt < nk; ++kt) {
    const bool issue = kt + 1 < nk;
    const int ibuf = buf ^ 1;
#pragma unroll
    for (int s2 = 0; s2 < 2; ++s2) {
      bf16x8 bf[4], af[MF];
      {
        const unsigned la = lds_base + buf * 65536 + ((wm * MF) << 11) + (s2 ? lofs1 : lofs0);
        const unsigned lb = lds_base + buf * 65536 + 32768 + ((wn * 4) << 11) + (s2 ? lofs1 : lofs0);
        if constexpr (MF == 8) {
          asm volatile(
              "ds_read_b128 %0, %13\n\tds_read_b128 %1, %13 offset:2048\n\tds_read_b128 %2, %13 offset:4096\n\tds_read_b128 %3, %13 offset:6144\n\t"
              "ds_read_b128 %4, %12\n\tds_read_b128 %5, %12 offset:2048\n\tds_read_b128 %6, %12 offset:4096\n\tds_read_b128 %7, %12 offset:6144\n\t"
              "ds_read_b128 %8, %12 offset:8192\n\tds_read_b128 %9, %12 offset:10240\n\tds_read_b128 %10, %12 offset:12288\n\tds_read_b128 %11, %12 offset:14336\n\t"
              "s_waitcnt lgkmcnt(0)"
              : "=&v"(bf[0]), "=&v"(bf[1]), "=&v"(bf[2]), "=&v"(bf[3]), "=&v"(af[0]), "=&v"(af[1]), "=&v"(af[2]), "=&v"(af[3]),
                "=&v"(af[4]), "=&v"(af[5]), "=&v"(af[6]), "=&v"(af[7])
              : "v"(la), "v"(lb)
              : "memory");
        } else {
          asm volatile(
              "ds_read_b128 %0, %9\n\tds_read_b128 %1, %9 offset:2048\n\tds_read_b128 %2, %9 offset:4096\n\tds_read_b128 %3, %9 offset:6144\n\t"
              "ds_read_b128 %4, %8\n\tds_read_b128 %5, %8 offset:2048\n\tds_read_b128 %6, %8 offset:4096\n\tds_read_b128 %7, %8 offset:6144\n\t"
              "s_waitcnt lgkmcnt(0)"
              : "=&v"(bf[0]), "=&v"(bf[1]), "=&v"(bf[2]), "=&v"(bf[3]), "=&v"(af[0]), "=&v"(af[1]), "=&v"(af[2]), "=&v"(af[3])
              : "v"(la), "v"(lb)
              : "memory");
        }
      }
      __builtin_amdgcn_sched_barrier(0);
      __builtin_amdgcn_s_setprio(1);
#pragma unroll
      for (int m = 0; m < MF; ++m) {
#pragma unroll
        for (int n = 0; n < 4; ++n) acc[m][n] = mfma16(bf[n], af[m], acc[m][n]);
        if constexpr (MF == 8) {
          if (m & 1) {
            __builtin_amdgcn_sched_barrier(0);
            if (issue) {
              if (s2 == 0) { if (m == 1) GEMM_PIECE_A(ibuf, 0); if (m == 3) GEMM_PIECE_A(ibuf, 1); if (m == 5) GEMM_PIECE_A(ibuf, 2); if (m == 7) GEMM_PIECE_A(ibuf, 3); }
              else { if (m == 1) GEMM_PIECE_B(ibuf, 0); if (m == 3) GEMM_PIECE_B(ibuf, 1); if (m == 5) GEMM_PIECE_B(ibuf, 2); if (m == 7) GEMM_PIECE_B(ibuf, 3); }
            }
            __builtin_amdgcn_sched_barrier(0);
          }
        } else {
          if (m < 3) {
            __builtin_amdgcn_sched_barrier(0);
            if (issue) {
              if (s2 == 0) { if (m == 0) GEMM_PIECE_A(ibuf, 0); if (m == 1) GEMM_PIECE_A(ibuf, 1); if (m == 2) GEMM_PIECE_B(ibuf, 0); }
              else { if (m == 0) GEMM_PIECE_B(ibuf, 1); if (m == 1) GEMM_PIECE_B(ibuf, 2); if (m == 2) GEMM_PIECE_B(ibuf, 3); }
            }
            __builtin_amdgcn_sched_barrier(0);
          }
        }
      }
      __builtin_amdgcn_s_setprio(0);
      __builtin_amdgcn_sched_barrier(0);
    }
    if (issue) { ag += 64; bg += 64; }
    GEMM_WAIT0;
    buf ^= 1;
  }
  const int rbase = m0 + wm * (MF * 16) + r;
  const int cbase = n0 + wn * 64 + q * 4;
  const int cb16 = n0 + wn * 64 + q * 16;
  float rsv[MF];
  constexpr bool PRE_X = (EPI == EPI_RESID || EPI == EPI_FINAL) && MF == 4;
  float xv[PRE_X ? MF : 1][16];
  if constexpr (EPI == EPI_FFNUP || EPI == EPI_WIN) {
#pragma unroll
    for (int m = 0; m < MF; ++m) rsv[m] = rsqrtf(e.ssq_in[rbase + m * 16] * (1.f / 1024.f) + 1e-6f);
  }
  if constexpr (PRE_X) {
    u32x4 xin[MF][2];
#pragma unroll
    for (int m = 0; m < MF; ++m) {
      const u16* xp = e.dst + (size_t)(rbase + m * 16) * e.ldd + cb16;
      xin[m][0] = *(const u32x4*)xp; xin[m][1] = *(const u32x4*)(xp + 8);
    }
#pragma unroll
    for (int m = 0; m < MF; ++m) {
#pragma unroll
      for (int i = 0; i < 4; ++i) {
        xv[m][2 * i] = bflo(xin[m][0][i]); xv[m][2 * i + 1] = bfhi(xin[m][0][i]);
        xv[m][8 + 2 * i] = bflo(xin[m][1][i]); xv[m][8 + 2 * i + 1] = bfhi(xin[m][1][i]);
      }
#pragma unroll
      for (int n = 0; n < 4; ++n)
#pragma unroll
        for (int j = 0; j < 4; ++j) xv[m][4 * n + j] += e.alpha * acc[m][n][j];
    }
  }
  if constexpr (EPI == EPI_FFNUP || EPI == EPI_WIN) {
#pragma unroll
    for (int m = 0; m < MF; ++m) asm volatile("" :: "v"(rsv[m]));
  }
  if constexpr (PRE_X) {
#pragma unroll
    for (int m = 0; m < MF; ++m)
      asm volatile("" :: "v"(xv[m][0]), "v"(xv[m][1]), "v"(xv[m][2]), "v"(xv[m][3]), "v"(xv[m][4]), "v"(xv[m][5]), "v"(xv[m][6]), "v"(xv[m][7]),
                   "v"(xv[m][8]), "v"(xv[m][9]), "v"(xv[m][10]), "v"(xv[m][11]), "v"(xv[m][12]), "v"(xv[m][13]), "v"(xv[m][14]), "v"(xv[m][15]));
  }
  __builtin_amdgcn_sched_barrier(0);
  if (has_next) {
    ag = g.A + (size_t)(nm0 + wave * (APW * 8) + pr) * g.lda + pc * 8;
    bg = g.B + (size_t)(nn0 + wave * 32 + pr) * g.ldb + pc * 8;
    GEMM_STAGE(0);
  }
  __builtin_amdgcn_sched_barrier(0);
#undef GEMM_STAGE
#undef GEMM_WAIT0
#undef GEMM_PIECE_A
#undef GEMM_PIECE_B
  if constexpr (EPI == EPI_FFNUP) {
#pragma unroll
    for (int m = 0; m < MF; ++m) {
      const int row = rbase + m * 16;
      const float rs = rsv[m];
      const int col = ((n0 + wn * 64) >> 1) + q * 8;
      float o[8];
#pragma unroll
      for (int pr = 0; pr < 2; ++pr)
#pragma unroll
        for (int j = 0; j < 4; ++j) o[pr * 4 + j] = siluf_(acc[m][2 * pr][j] * rs) * (acc[m][2 * pr + 1][j] * rs);
      u32x4 v = {pack2(o[0], o[1]), pack2(o[2], o[3]), pack2(o[4], o[5]), pack2(o[6], o[7])};
      *(u32x4*)(e.dst + (size_t)row * e.ldd + col) = v;
    }
  } else if constexpr (EPI == EPI_RESID || EPI == EPI_FINAL) {
#pragma unroll
    for (int m = 0; m < MF; ++m) {
      const int row = rbase + m * 16;
      float ss = 0.f;
      float* yrow = nullptr;
      if constexpr (EPI == EPI_FINAL) {
        if (row < M_P) {
          int b = row / TP, pp = row % TP;
          if (pp >= 16) yrow = e.out + O_YP + ((size_t)b * 4096 + (pp - 16)) * 1024;
        } else yrow = e.out + O_YS + (size_t)(row - M_P) * 1024;
      }
      u16* xp = e.dst + (size_t)row * e.ldd + cb16;
      float x[16];
      if constexpr (PRE_X) {
#pragma unroll
        for (int i = 0; i < 16; ++i) x[i] = xv[m][i];
      } else {
        const u32x4 xa = *(const u32x4*)xp, xb = *(const u32x4*)(xp + 8);
#pragma unroll
        for (int i = 0; i < 4; ++i) {
          x[2 * i] = bflo(xa[i]); x[2 * i + 1] = bfhi(xa[i]);
          x[8 + 2 * i] = bflo(xb[i]); x[8 + 2 * i + 1] = bfhi(xb[i]);
        }
#pragma unroll
        for (int n = 0; n < 4; ++n)
#pragma unroll
          for (int j = 0; j < 4; ++j) x[4 * n + j] += e.alpha * acc[m][n][j];
      }
      if constexpr (EPI == EPI_RESID) {
        u32x4 va = {pack2(x[0], x[1]), pack2(x[2], x[3]), pack2(x[4], x[5]), pack2(x[6], x[7])};
        u32x4 vb = {pack2(x[8], x[9]), pack2(x[10], x[11]), pack2(x[12], x[13]), pack2(x[14], x[15])};
        *(u32x4*)xp = va; *(u32x4*)(xp + 8) = vb;
#pragma unroll
        for (int i = 0; i < 4; ++i) {
          x[2 * i] = bflo(va[i]); x[2 * i + 1] = bfhi(va[i]);
          x[8 + 2 * i] = bflo(vb[i]); x[8 + 2 * i + 1] = bfhi(vb[i]);
        }
      } else {
        if (yrow) {
#pragma unroll
          for (int i = 0; i < 4; ++i) *(float4*)(yrow + cb16 + 4 * i) = make_float4(x[4 * i], x[4 * i + 1], x[4 * i + 2], x[4 * i + 3]);
        }
      }
#pragma unroll
      for (int i = 0; i < 16; ++i) ss += x[i] * x[i];
      ss += __shfl_xor(ss, 16);
      ss += __shfl_xor(ss, 32);
      if (q == 0) atomicAdd(e.ssq_out + row, ss);
    }
  } else if constexpr (EPI == EPI_WIN) {
#pragma unroll
    for (int m = 0; m < MF; ++m) {
      const int row = rbase + m * 16;
      const float rs = rsv[m];
      float* sh = nullptr;
      if (row < M_P) { if (row % TP == TP - 1) sh = e.out + O_SHP + (size_t)(row / TP) * 1792; }
      else if (((row - M_P) & 63) == 63) sh = e.out + O_SHS + (size_t)((row - M_P) >> 6) * 1792;
      if (cb16 < NIN) {
        float x[16];
#pragma unroll
        for (int n = 0; n < 4; ++n)
#pragma unroll
          for (int j = 0; j < 4; ++j) x[4 * n + j] = acc[m][n][j] * rs;
        u32x4 va = {pack2(x[0], x[1]), pack2(x[2], x[3]), pack2(x[4], x[5]), pack2(x[6], x[7])};
        u32x4 vb = {pack2(x[8], x[9]), pack2(x[10], x[11]), pack2(x[12], x[13]), pack2(x[14], x[15])};
        u16* dp = e.dst + (size_t)row * e.ldd + cb16;
        *(u32x4*)dp = va; *(u32x4*)(dp + 8) = vb;
        if (sh && cb16 < 1792) {
#pragma unroll
          for (int i = 0; i < 4; ++i) *(float4*)(sh + cb16 + 4 * i) = make_float4(x[4 * i], x[4 * i + 1], x[4 * i + 2], x[4 * i + 3]);
        }
      }
    }
  } else if constexpr (EPI == EPI_Q) {
#pragma unroll
    for (int m = 0; m < MF; ++m) {
      const int row = rbase + m * 16;
      const int pos = row_pos(row);
#pragma unroll
      for (int n = 0; n < 4; ++n) {
        const int col = cbase + n * 16;
        const int hc = col % 96;
        float v0 = acc[m][n][0], v1 = acc[m][n][1], v2 = acc[m][n][2], v3 = acc[m][n][3];
        if (hc >= 64) {
          const int f0 = (hc - 64) & 15;
          const float4 cs01 = *(const float4*)(e.rope + pos * 16 + f0);
          const float4 cs23 = *(const float4*)(e.rope + pos * 16 + f0 + 2);
          if (hc < 80) {
            if (n < 3) {
              const f32x4 o = acc[m][n < 3 ? n + 1 : n];
              v0 = v0 * cs01.x - o[0] * cs01.y; v1 = v1 * cs01.z - o[1] * cs01.w;
              v2 = v2 * cs23.x - o[2] * cs23.y; v3 = v3 * cs23.z - o[3] * cs23.w;
            }
          } else {
            if (n > 0) {
              const f32x4 o = acc[m][n > 0 ? n - 1 : n];
              v0 = o[0] * cs01.y + v0 * cs01.x; v1 = o[1] * cs01.w + v1 * cs01.z;
              v2 = o[2] * cs23.y + v2 * cs23.x; v3 = o[3] * cs23.w + v3 * cs23.z;
            }
          }
        }
        u32x2 v = {pack2(v0, v1), pack2(v2, v3)};
        *(u32x2*)(e.dst + (size_t)row * e.ldd + col) = v;
      }
    }
  } else if constexpr (EPI == EPI_KN) {
#pragma unroll
    for (int m = 0; m < MF; ++m) {
      const int row = rbase + m * 16;
      if (row < e.rows_valid) {
        const int h = cb16 >> 6, d = cb16 & 63;
        u32x4 va = {pack2(acc[m][0][0], acc[m][0][1]), pack2(acc[m][0][2], acc[m][0][3]), pack2(acc[m][1][0], acc[m][1][1]), pack2(acc[m][1][2], acc[m][1][3])};
        u32x4 vb = {pack2(acc[m][2][0], acc[m][2][1]), pack2(acc[m][2][2], acc[m][2][3]), pack2(acc[m][3][0], acc[m][3][1]), pack2(acc[m][3][2], acc[m][3][3])};
        u16* dp = e.dst + (size_t)row * 768 + h * 96 + d;
        *(u32x4*)dp = va; *(u32x4*)(dp + 8) = vb;
      }
    }
  } else if constexpr (EPI == EPI_VT) {
#pragma unroll
    for (int m = 0; m < MF; ++m) {
      const int row = rbase + m * 16;
#pragma unroll
      for (int n = 0; n < 4; ++n) {
        const int col = cbase + n * 16;
        u32x2 v = {pack2(acc[m][n][0], acc[m][n][1]), pack2(acc[m][n][2], acc[m][n][3])};
        *(u32x2*)(e.dst + (size_t)row * e.ldd + col) = v;
      }
    }
  }
}

struct XcdInfo { int xcd, slot, nbx; };
template <int EPI, int MF>
__device__ __forceinline__ void gemm_phase(const GemmArgs g, const EpiArgs e, int mtiles, int ntiles, unsigned char* smem, const XcdInfo xi, const int nchunk, const int m_base = 0) {
  const int nb = gridDim.x;
  constexpr int BM = MF * 32;
  const bool can_pre = !((EPI == EPI_RESID || EPI == EPI_FINAL) && MF == 8);
  if (xi.nbx > 0) {
    const int xcd = xi.xcd, slot = xi.slot, nbx = xi.nbx;
    const int mloc = (mtiles + 7) >> 3;
    constexpr int GS = 2;
    const int mgroups = (mloc + GS - 1) / GS;
    const int total = nchunk == 0 ? mgroups * GS * ntiles : mloc * ntiles;
    auto decode = [&](int L, int& m, int& n) {
      if (nchunk == 0) {
        const int mg = L / (GS * ntiles), rem = L % (GS * ntiles);
        m = (mg * GS + (rem & (GS - 1))) * 8 + xcd; n = rem / GS;
      } else {
        int c = 0;
#pragma unroll
        for (int cc = 1; cc < 4; ++cc) if (cc < nchunk && L >= mloc * ((cc * ntiles) / nchunk)) c = cc;
        const int ns = (c * ntiles) / nchunk, ne = ((c + 1) * ntiles) / nchunk, cn = ne - ns;
        const int rem = L - mloc * ns;
        m = (rem / cn) * 8 + xcd; n = ns + rem % cn;
      }
    };
    auto tile_m = [&](int L) { int m, n; decode(L, m, n); return m; };
    auto tile_n = [&](int L) { int m, n; decode(L, m, n); return n; };
    auto next_valid = [&](int L) { while (L < total && tile_m(L) >= mtiles) L += nbx; return L; };
    int L = next_valid(slot);
    bool pre = false;
    while (L < total) {
      const int Ln = next_valid(L + nbx);
      const bool hn = can_pre && Ln < total;
      gemm_tile<EPI, MF>(g, m_base + tile_m(L) * BM, tile_n(L) * 256, smem, e, pre, hn, hn ? m_base + tile_m(Ln) * BM : 0, hn ? tile_n(Ln) * 256 : 0);
      pre = hn; L = Ln;
    }
  } else {
    const int total = mtiles * ntiles;
    int t = blockIdx.x;
    bool pre = false;
    while (t < total) {
      const int tn = t + nb;
      const bool hn = can_pre && tn < total;
      gemm_tile<EPI, MF>(g, m_base + (t / ntiles) * BM, (t % ntiles) * 256, smem, e, pre, hn, hn ? m_base + (tn / ntiles) * BM : 0, hn ? (tn % ntiles) * 256 : 0);
      pre = hn; t = tn;
    }
  }
}

__device__ __forceinline__ void phase_mla_prep(const Params& p) {
  const u16* P = (const u16*)(p.ws + WS_P);
  u16* CQN = (u16*)(p.ws + WS_CQN);
  u16* CB = (u16*)(p.ws + WS_CB);
  u16* KALL = (u16*)(p.ws + WS_KALL);
  const float2* rope = (const float2*)(p.ws + WS_ROPE);
  const float* gkv = p.in[26];
  const int lane = threadIdx.x & 63, wave = threadIdx.x >> 6;
  const float g0 = gkv[lane * 2], g1 = gkv[lane * 2 + 1];
  const int rstride = gridDim.x * NWAVES;
  for (int row0 = blockIdx.x * NWAVES + wave; row0 < KS_TOT; row0 += 2 * rstride) {
    int rows[2], prow[2], pos[2]; bool ok[2];
    u32x2 qv[2]; u32 cv[2]; float x1[2], x2[2]; float2 cs[2]; float cf0[2], cf1[2], kf0[2], kf1[2];
#pragma unroll
    for (int u = 0; u < 2; ++u) {
      int row = row0 + u * rstride; ok[u] = row < KS_TOT; if (!ok[u]) row = row0; rows[u] = row;
      prow[u] = -1; pos[u] = 0; int cache_idx = 0;
      if (row < M_TOT) { prow[u] = row; pos[u] = row_pos(row); }
      else {
        int sr = row - M_TOT, bd = sr / KS_S, idx = sr % KS_S;
        pos[u] = idx;
        if (idx < 16) prow[u] = idx;
        else if (idx >= 2064) prow[u] = M_P + bd * 64 + (idx - 2064);
        else cache_idx = bd * 2048 + (idx - 16);
      }
      qv[u] = (u32x2){0u, 0u}; cv[u] = 0u; x1[u] = x2[u] = 0.f; cs[u] = make_float2(1.f, 0.f); cf0[u] = cf1[u] = kf0[u] = kf1[u] = 0.f;
      if (prow[u] >= 0) {
        const u16* pr = P + (size_t)prow[u] * NIN;
        if (row < M_TOT) qv[u] = *(const u32x2*)(pr + 1792 + lane * 4);
        cv[u] = *(const u32*)(pr + 2048 + lane * 2);
        if (lane < 16) { x1[u] = bf2f(pr[2176 + lane]); x2[u] = bf2f(pr[2176 + 16 + lane]); cs[u] = rope[pos[u] * 16 + lane]; }
      } else {
        const float* cc = p.in[2] + (size_t)cache_idx * 128;
        cf0[u] = cc[lane * 2]; cf1[u] = cc[lane * 2 + 1];
        if (lane < 16) { const float* kr = p.in[3] + (size_t)cache_idx * 32; kf0[u] = kr[lane]; kf1[u] = kr[lane + 16]; }
      }
    }
#pragma unroll
    for (int u = 0; u < 2; ++u) {
      const int row = rows[u];
      float c0, c1, k0 = 0.f, k1 = 0.f;
      if (prow[u] >= 0) {
        if (row < M_TOT) {
          float a0 = bflo(qv[u][0]), a1 = bfhi(qv[u][0]), a2 = bflo(qv[u][1]), a3 = bfhi(qv[u][1]);
          float s = wave_sum(a0 * a0 + a1 * a1 + a2 * a2 + a3 * a3);
          float rs = rsqrtf(s * (1.f / 256.f) + 1e-6f);
          u32x2 o = {pack2(a0 * rs, a1 * rs), pack2(a2 * rs, a3 * rs)};
          if (ok[u]) *(u32x2*)(CQN + (size_t)row * 256 + lane * 4) = o;
        }
        c0 = bflo(cv[u]); c1 = bfhi(cv[u]);
        float s = wave_sum(c0 * c0 + c1 * c1);
        float rs = rsqrtf(s * (1.f / 128.f) + 1e-6f);
        c0 = c0 * rs * g0; c1 = c1 * rs * g1;
        if (lane < 16) { k0 = x1[u] * cs[u].x - x2[u] * cs[u].y; k1 = x1[u] * cs[u].y + x2[u] * cs[u].x; }
      } else {
        c0 = cf0[u]; c1 = cf1[u]; k0 = kf0[u]; k1 = kf1[u];
      }
      if (ok[u]) {
        *(u32*)(CB + (size_t)row * 128 + lane * 2) = pack2(c0, c1);
        if (lane < 16) {
          u16 b0 = f2bf(k0), b1 = f2bf(k1);
#pragma unroll
          for (int h = 0; h < 8; ++h) {
            KALL[(size_t)row * 768 + h * 96 + 64 + lane] = b0;
            KALL[(size_t)row * 768 + h * 96 + 80 + lane] = b1;
          }
        }
        if (row < M_TOT) {
          float* oc; float* okp;
          if (row < M_P) { oc = p.out + O_CKVP + (size_t)row * 128; okp = p.out + O_KRP + (size_t)row * 32; }
          else { oc = p.out + O_CKVS + (size_t)(row - M_P) * 128; okp = p.out + O_KRS + (size_t)(row - M_P) * 32; }
          *(float2*)(oc + lane * 2) = make_float2(c0, c1);
          if (lane < 16) { okp[lane] = k0; okp[lane + 16] = k1; }
        }
      }
    }
  }
}

__device__ __forceinline__ void phase_mla_gemms(const Params& p, unsigned char* smem) {
  const int T_Q = 259 * 3, T_K = 326 * 2, T_VP = 16 * 2 * 17, T_VS = 8 * 2 * 9;
  const int total = T_Q + T_K + T_VP + T_VS;
  for (int t = blockIdx.x; t < total; t += gridDim.x) {
    if (t < T_Q) {
      GemmArgs g{(const u16*)(p.ws + WS_CQN), 256, (const u16*)(p.ws + WS_WQ), 256, 256};
      EpiArgs e{}; e.dst = (u16*)(p.ws + WS_Q); e.ldd = 768; e.rope = (const float2*)(p.ws + WS_ROPE);
      gemm_tile<EPI_Q, 8>(g, (t / 3) * 256, (t % 3) * 256, smem, e);
    } else if (t < T_Q + T_K) {
      int u = t - T_Q;
      GemmArgs g{(const u16*)(p.ws + WS_CB), 128, (const u16*)(p.ws + WS_WUK), 128, 128};
      EpiArgs e{}; e.dst = (u16*)(p.ws + WS_KALL); e.rows_valid = KS_TOT;
      gemm_tile<EPI_KN, 8>(g, (u >> 1) * 256, (u & 1) * 256, smem, e);
    } else {
      int u = t - T_Q - T_K;
      int s, mt, nt; long rowbase; u16* dst; long ldd;
      if (u < T_VP) { s = u / 34; int v = u % 34; mt = v / 17; nt = v % 17; rowbase = (long)s * TP;
        dst = (u16*)(p.ws + WS_VTP) + (size_t)s * 512 * TPAD_P; ldd = TPAD_P; }
      else { u -= T_VP; s = u / 18; int v = u % 18; mt = v / 9; nt = v % 9; rowbase = (long)M_TOT + (long)s * KS_S;
        dst = (u16*)(p.ws + WS_VTS) + (size_t)s * 512 * TPAD_S; ldd = TPAD_S; }
      GemmArgs g{(const u16*)(p.ws + WS_WUV), 128, (const u16*)(p.ws + WS_CB) + rowbase * 128, 128, 128};
      EpiArgs e{}; e.dst = dst; e.ldd = ldd;
      gemm_tile<EPI_VT, 8>(g, mt * 256, nt * 256, smem, e);
    }
  }
}

DI int vswz(int r, int c4) { return r * 64 + ((c4 ^ (r >> 2)) << 4); }

struct AttnItem {
  const u16* Q; const u16* Kb; const u16* Vt; long ldv;
  u16* O; int nq_valid; int ntiles;
  int wt_base, wt_step;
};

__device__ __forceinline__ void attn_item(const AttnItem it, unsigned char* smem) {
  int tid = threadIdx.x;
  asm volatile("" : "+v"(tid));
  const int lane = tid & 63, wave = tid >> 6;
  const int r = lane & 15, q = lane >> 4;
  const int my_tiles = it.wt_base + (wave >> 1) * it.wt_step;
  bf16x8 qf[2][3];
#pragma unroll
  for (int f = 0; f < 2; ++f) {
    int qr = wave * 32 + f * 16 + r;
    if (qr >= it.nq_valid) qr = it.nq_valid - 1;
#pragma unroll
    for (int ks = 0; ks < 3; ++ks) qf[f][ks] = *(const bf16x8*)(it.Q + (size_t)qr * 768 + ks * 32 + q * 8);
  }
  f32x4 o[4][2];
#pragma unroll
  for (int d = 0; d < 4; ++d)
#pragma unroll
    for (int f = 0; f < 2; ++f) o[d][f] = (f32x4){0.f, 0.f, 0.f, 0.f};
  float mrun[2] = {-1e30f, -1e30f}, lrun[2] = {0.f, 0.f};
  u32x4 rk[2], rv;
  int kofs[2], vofs;
  const u16* kptr[2]; const u16* vptr;
  const bool k2 = tid < 256;
#pragma unroll
  for (int i = 0; i < 2; ++i) {
    int c = tid + i * 512; if (c >= 768) c = 767; int key = c / 12, kc = c % 12;
    kptr[i] = it.Kb + (size_t)key * 768 + kc * 8;
    kofs[i] = (((key >> 4) * 3 + (kc >> 2)) << 10) + swz(key & 15, kc & 3);
  }
  {
    int c = tid; int dv = c >> 3, kc = c & 7;
    vptr = it.Vt + (size_t)dv * it.ldv + kc * 8;
    vofs = (((dv >> 4) * 2 + (kc >> 2)) << 10) + vswz(dv & 15, kc & 3);
  }
  const int nt_all = it.ntiles + 1;
  rk[0] = *(const u32x4*)(kptr[0]);
  rk[1] = *(const u32x4*)(kptr[1]);
  rv = *(const u32x4*)(vptr);
  __syncthreads();
  {
    unsigned char* sK = smem; unsigned char* sV = smem + 12288;
    *(u32x4*)(sK + kofs[0]) = rk[0];
    if (k2) *(u32x4*)(sK + kofs[1]) = rk[1];
    *(u32x4*)(sV + vofs) = rv;
  }
  __syncthreads();
  auto tile_body = [&](auto meta_tag, const unsigned char* sK, const unsigned char* sV) {
    constexpr bool META = decltype(meta_tag)::value;
    constexpr int NKF = META ? 1 : 4;
    constexpr int NKS = META ? 1 : 2;
    f32x4 s[NKF][2];
#pragma unroll
    for (int kf = 0; kf < NKF; ++kf)
#pragma unroll
      for (int f = 0; f < 2; ++f) s[kf][f] = (f32x4){0.f, 0.f, 0.f, 0.f};
#pragma unroll
    for (int kf = 0; kf < NKF; ++kf) {
#pragma unroll
      for (int ks = 0; ks < 3; ++ks) {
        bf16x8 kfr = *(const bf16x8*)(sK + ((kf * 3 + ks) << 10) + swz(r, q));
#pragma unroll
        for (int f = 0; f < 2; ++f) s[kf][f] = mfma16(kfr, qf[f][ks], s[kf][f]);
      }
    }
    float mx[2];
#pragma unroll
    for (int f = 0; f < 2; ++f) {
      float m_ = s[0][f][0];
#pragma unroll
      for (int kf = 0; kf < NKF; ++kf)
#pragma unroll
        for (int j = 0; j < 4; ++j) m_ = fmaxf(m_, s[kf][f][j]);
      m_ = fmaxf(m_, __shfl_xor(m_, 16));
      m_ = fmaxf(m_, __shfl_xor(m_, 32));
      mx[f] = m_;
    }
    const bool need = (mx[0] > mrun[0] + 8.f) || (mx[1] > mrun[1] + 8.f);
    if (__builtin_amdgcn_ballot_w64(need) != 0ull) {
#pragma unroll
      for (int f = 0; f < 2; ++f) {
        const float mnew = fmaxf(mrun[f], mx[f]);
        const float alpha = __builtin_amdgcn_exp2f(mrun[f] - mnew);
        mrun[f] = mnew;
        lrun[f] *= alpha;
#pragma unroll
        for (int d = 0; d < 4; ++d)
#pragma unroll
          for (int j = 0; j < 4; ++j) o[d][f][j] *= alpha;
      }
    }
    bf16x8 pf[2][NKS];
#pragma unroll
    for (int f = 0; f < 2; ++f) {
      float pv[NKF][4];
      float ps = 0.f;
#pragma unroll
      for (int kf = 0; kf < NKF; ++kf)
#pragma unroll
        for (int j = 0; j < 4; ++j) { pv[kf][j] = __builtin_amdgcn_exp2f(s[kf][f][j] - mrun[f]); ps += pv[kf][j]; }
      lrun[f] += ps;
      if constexpr (META) {
        u32x4 w = {pack2(pv[0][0], pv[0][1]), pack2(pv[0][2], pv[0][3]), 0u, 0u};
        pf[f][0] = __builtin_bit_cast(bf16x8, w);
      } else {
#pragma unroll
        for (int ks = 0; ks < 2; ++ks) {
          u32x4 w = {pack2(pv[2 * ks][0], pv[2 * ks][1]), pack2(pv[2 * ks][2], pv[2 * ks][3]),
                     pack2(pv[2 * ks + 1][0], pv[2 * ks + 1][1]), pack2(pv[2 * ks + 1][2], pv[2 * ks + 1][3])};
          pf[f][ks] = __builtin_bit_cast(bf16x8, w);
        }
      }
    }
#pragma unroll
    for (int ks = 0; ks < NKS; ++ks) {
#pragma unroll
      for (int d = 0; d < 4; ++d) {
        const unsigned char* vb = sV + ((d * 2 + ks) << 10) + r * 64;
        const int x = (r >> 2) << 1;
        u32x2 lo = *(const u32x2*)(vb + (((q) ^ x) << 3));
        u32x2 hi = *(const u32x2*)(vb + (((4 + q) ^ x) << 3));
        u32x4 w = {lo[0], lo[1], hi[0], hi[1]};
        bf16x8 vf = __builtin_bit_cast(bf16x8, w);
#pragma unroll
        for (int f = 0; f < 2; ++f) o[d][f] = mfma16(vf, pf[f][ks], o[d][f]);
      }
    }
  };
#pragma unroll 1
  for (int ti = 0; ti < nt_all; ++ti) {
    unsigned char* sK = smem + (ti & 1) * 20480; unsigned char* sV = sK + 12288;
    if (ti + 1 < nt_all) {
      const long koff = 16 + 64 * (long)ti;
      rk[0] = *(const u32x4*)(kptr[0] + koff * 768);
      rk[1] = *(const u32x4*)(kptr[1] + koff * 768);
      rv = *(const u32x4*)(vptr + koff);
    }
    if (ti == 0) tile_body(std::true_type{}, sK, sV);
    else if (ti <= my_tiles) tile_body(std::false_type{}, sK, sV);
    if (ti + 1 < nt_all) {
      unsigned char* nK = smem + ((ti + 1) & 1) * 20480; unsigned char* nV = nK + 12288;
      *(u32x4*)(nK + kofs[0]) = rk[0];
      if (k2) *(u32x4*)(nK + kofs[1]) = rk[1];
      *(u32x4*)(nV + vofs) = rv;
    }
    __syncthreads();
  }
#pragma unroll
  for (int f = 0; f < 2; ++f) {
    float l = lrun[f];
    l += __shfl_xor(l, 16);
    l += __shfl_xor(l, 32);
    const float inv = 1.f / l;
    const int qr = wave * 32 + f * 16 + r;
    if (qr < it.nq_valid) {
#pragma unroll
      for (int d = 0; d < 4; ++d) {
        u32x2 v = {pack2(o[d][f][0] * inv, o[d][f][1] * inv), pack2(o[d][f][2] * inv, o[d][f][3] * inv)};
        *(u32x2*)(it.O + (size_t)qr * 1024 + d * 16 + q * 4) = v;
      }
    }
  }
}

__device__ __forceinline__ void scan_item(const Params& p, int stream, int h, unsigned char* smem) {
  int tid = threadIdx.x;
  asm volatile("" : "+v"(tid));
  const int hf = tid >> 8;
  unsigned char* const smem0 = smem;
  smem += hf * 61440;
  tid &= 255;
  const int lane = tid & 63, wave = tid >> 6;
  const int r = lane & 15, q = lane >> 4;
  const bool is_p = stream < 16;
  const int T = is_p ? TP : 64;
  const long row0 = is_p ? (long)stream * TP : (long)M_P + (long)(stream - 16) * 64;
  const u16* P = (const u16*)(p.ws + WS_P);
  u16* MIX = (u16*)(p.ws + WS_MIX);
  const float* mu = p.in[13];
  const float* shift0 = is_p ? nullptr : p.in[5] + (size_t)(stream - 16) * 1792;
  float* sW = (float*)smem;
  float* sKp = sW + 1024;
  float* sNKK = sKp + 1024;
  float* sKKA = sNKK + 1024;
  float* sR = sKKA + 1024;
  float* sV = sR + 1024;
  float* sG = sV + 1024;
  float* sY = sG + 1024;
  float* sRK = sY + 1024;
  unsigned char* sTW = (unsigned char*)(sRK + 64);
  unsigned char* sAL = sTW + 2048;
  unsigned char* sSG = sAL + 2048;
  unsigned char* imgA = sSG + 4096;
  unsigned char* imgR = imgA + 2304;
  unsigned char* imgB = imgR + 2304;
  unsigned char* imgK = imgB + 2304;
  unsigned char* sBKT = imgK + 2304;
  unsigned char* sMAT = sBKT + 4608;
  float* sNab = (float*)(sMAT + 2560);
  float* sGam = sNab + 256;
  unsigned char* sTT = (unsigned char*)(sGam + 64);
  const int chw = h * 64 + wave * 16 + r;
  bf16x8 bw[2], ba[2], bg[4];
  {
    const u16* Ww = (const u16*)(p.ws + WS_WW2) + (size_t)chw * 64;
    const u16* Wa = (const u16*)(p.ws + WS_WA2) + (size_t)chw * 64;
    const u16* Wg = (const u16*)(p.ws + WS_WG2) + (size_t)chw * 128;
#pragma unroll
    for (int ks = 0; ks < 2; ++ks) { bw[ks] = *(const bf16x8*)(Ww + ks * 32 + q * 8); ba[ks] = *(const bf16x8*)(Wa + ks * 32 + q * 8); }
#pragma unroll
    for (int ks = 0; ks < 4; ++ks) bg[ks] = *(const bf16x8*)(Wg + ks * 32 + q * 8);
  }
  const float w0c = p.in[14][chw], a0c = p.in[16][chw];
  const int et = tid >> 4, ec = (tid & 15) * 4;
  const int hc = h * 64 + ec;
  const int lseg = (tid & 15) * 16;
  float S[4][4];
  const int vme = wave * 16 + r;
  if (is_p) {
#pragma unroll
    for (int g = 0; g < 4; ++g)
#pragma unroll
      for (int j = 0; j < 4; ++j) S[g][j] = 0.f;
  } else {
    const float* st = p.in[4] + ((size_t)(stream - 16) * 8 + h) * 4096;
#pragma unroll
    for (int g = 0; g < 4; ++g) {
      float4 v = *(const float4*)(st + vme * 64 + g * 16 + q * 4);
      S[g][0] = v.x; S[g][1] = v.y; S[g][2] = v.z; S[g][3] = v.w;
    }
  }
  u32x2 g_cr, g_pr, g_ck, g_pk, g_cv, g_pv;
  u32x4 g_cl0, g_cl1, g_pl0, g_pl1;
#define SCAN_LOAD(T0)                                                              \
  do {                                                                             \
    long _row = row0 + (T0) + et; if (_row > M_TOT - 1) _row = M_TOT - 1;          \
    long _prow = _row > 0 ? _row - 1 : 0;                                          \
    const u16* _pc = P + (size_t)_row * NIN; const u16* _pp = P + (size_t)_prow * NIN; \
    g_cr = *(const u32x2*)(_pc + hc); g_pr = *(const u32x2*)(_pp + hc);            \
    g_ck = *(const u32x2*)(_pc + 512 + hc); g_pk = *(const u32x2*)(_pp + 512 + hc); \
    g_cv = *(const u32x2*)(_pc + 1024 + hc); g_pv = *(const u32x2*)(_pp + 1024 + hc); \
    g_cl0 = *(const u32x4*)(_pc + 1536 + lseg); g_cl1 = *(const u32x4*)(_pc + 1536 + lseg + 8); \
    g_pl0 = *(const u32x4*)(_pp + 1536 + lseg); g_pl1 = *(const u32x4*)(_pp + 1536 + lseg + 8); \
  } while (0)
  SCAN_LOAD(16 * hf);
  __syncthreads();
#pragma unroll 1
  for (int tb = 0; tb < T; tb += 32) {
    const int t0 = tb + 16 * hf;
    {
      float mu_r[4], mu_k[4], mu_v[4];
      {
        const float4 a4 = *(const float4*)(mu + hc), b4 = *(const float4*)(mu + 512 + hc), c4v = *(const float4*)(mu + 1024 + hc);
        mu_r[0] = a4.x; mu_r[1] = a4.y; mu_r[2] = a4.z; mu_r[3] = a4.w;
        mu_k[0] = b4.x; mu_k[1] = b4.y; mu_k[2] = b4.z; mu_k[3] = b4.w;
        mu_v[0] = c4v.x; mu_v[1] = c4v.y; mu_v[2] = c4v.z; mu_v[3] = c4v.w;
      }
      const bool first = (t0 + et) == 0;
      float rr[4], kk_[4], vv[4];
      {
        u32x2 c = g_cr, pv = first ? (u32x2){0u, 0u} : g_pr;
        float cf[4] = {bflo(c[0]), bfhi(c[0]), bflo(c[1]), bfhi(c[1])};
        float pf[4] = {bflo(pv[0]), bfhi(pv[0]), bflo(pv[1]), bfhi(pv[1])};
        if (first && shift0) { float4 s4 = *(const float4*)(shift0 + hc); pf[0] = s4.x; pf[1] = s4.y; pf[2] = s4.z; pf[3] = s4.w; }
#pragma unroll
        for (int j = 0; j < 4; ++j) rr[j] = cf[j] + mu_r[j] * (pf[j] - cf[j]);
      }
      {
        u32x2 c = g_ck, pv = first ? (u32x2){0u, 0u} : g_pk;
        float cf[4] = {bflo(c[0]), bfhi(c[0]), bflo(c[1]), bfhi(c[1])};
        float pf[4] = {bflo(pv[0]), bfhi(pv[0]), bflo(pv[1]), bfhi(pv[1])};
        if (first && shift0) { float4 s4 = *(const float4*)(shift0 + 512 + hc); pf[0] = s4.x; pf[1] = s4.y; pf[2] = s4.z; pf[3] = s4.w; }
#pragma unroll
        for (int j = 0; j < 4; ++j) kk_[j] = cf[j] + mu_k[j] * (pf[j] - cf[j]);
      }
      {
        u32x2 c = g_cv, pv = first ? (u32x2){0u, 0u} : g_pv;
        float cf[4] = {bflo(c[0]), bfhi(c[0]), bflo(c[1]), bfhi(c[1])};
        float pf[4] = {bflo(pv[0]), bfhi(pv[0]), bflo(pv[1]), bfhi(pv[1])};
        if (first && shift0) { float4 s4 = *(const float4*)(shift0 + 1024 + hc); pf[0] = s4.x; pf[1] = s4.y; pf[2] = s4.z; pf[3] = s4.w; }
#pragma unroll
        for (int j = 0; j < 4; ++j) vv[j] = cf[j] + mu_v[j] * (pf[j] - cf[j]);
      }
      *(float4*)(sR + et * 64 + ec) = make_float4(rr[0], rr[1], rr[2], rr[3]);
      *(float4*)(sKp + et * 64 + ec) = make_float4(kk_[0], kk_[1], kk_[2], kk_[3]);
      *(float4*)(sV + et * 64 + ec) = make_float4(vv[0], vv[1], vv[2], vv[3]);
      {
        unsigned char* base; int kcol;
        if (lseg < 64) { base = sTW; kcol = lseg; }
        else if (lseg < 128) { base = sAL; kcol = lseg - 64; }
        else { base = sSG; kcol = lseg - 128; }
        const int st = kcol >> 5, c4 = (kcol & 31) >> 3;
#pragma unroll
        for (int hf = 0; hf < 2; ++hf) {
          const u32x4 cc = hf ? g_cl1 : g_cl0;
          u32x4 pq = {0u, 0u, 0u, 0u};
          if (!first) pq = hf ? g_pl1 : g_pl0;
          float cf[8], pf[8], lv[8];
#pragma unroll
          for (int j = 0; j < 4; ++j) {
            cf[2 * j] = bflo(cc[j]); cf[2 * j + 1] = bfhi(cc[j]);
            pf[2 * j] = bflo(pq[j]); pf[2 * j + 1] = bfhi(pq[j]);
          }
          if (first && shift0) {
#pragma unroll
            for (int j = 0; j < 8; ++j) pf[j] = shift0[1536 + lseg + hf * 8 + j];
          }
          const float4 m0 = *(const float4*)(mu + 1536 + lseg + hf * 8), m1 = *(const float4*)(mu + 1536 + lseg + hf * 8 + 4);
          const float mul[8] = {m0.x, m0.y, m0.z, m0.w, m1.x, m1.y, m1.z, m1.w};
          const float act_s = lseg < 64 ? 2.f : 1.f;
#pragma unroll
          for (int j = 0; j < 8; ++j) {
            const float sft = cf[j] + mul[j] * (pf[j] - cf[j]);
            const float sg = frcp(1.f + __expf(-act_s * sft));
            lv[j] = lseg < 64 ? 2.f * sg - 1.f : (lseg >= 128 ? sg : sft);
          }
          u32x4 w0 = {pack2(lv[0], lv[1]), pack2(lv[2], lv[3]), pack2(lv[4], lv[5]), pack2(lv[6], lv[7])};
          *(u32x4*)(base + (st << 10) + swz(et, c4 + hf)) = w0;
        }
      }
      if (tb + 32 < T) SCAN_LOAD(t0 + 32);
    }
    __syncthreads();
    {
      f32x4 dw = {0.f, 0.f, 0.f, 0.f}, da = dw, dg = dw;
#pragma unroll
      for (int ks = 0; ks < 2; ++ks) {
        bf16x8 aw = *(const bf16x8*)(sTW + (ks << 10) + swz(r, q));
        bf16x8 aa = *(const bf16x8*)(sAL + (ks << 10) + swz(r, q));
        dw = mfma16(aw, bw[ks], dw);
        da = mfma16(aa, ba[ks], da);
      }
#pragma unroll
      for (int ks = 0; ks < 4; ++ks) {
        bf16x8 ag = *(const bf16x8*)(sSG + (ks << 10) + swz(r, q));
        dg = mfma16(ag, bg[ks], dg);
      }
      const int ch = wave * 16 + r;
#pragma unroll
      for (int jj = 0; jj < 4; ++jj) {
        const int tk = q * 4 + jj;
        float z = -(w0c + dw[jj]);
        float sp = z > 20.f ? z : __logf(1.f + __expf(z));
        float logw = -sp - 0.5f;
        sW[tk * 64 + ch] = __expf(-__expf(logw));
        sKKA[tk * 64 + ch] = sigmoidf_(a0c + da[jj]);
        sG[tk * 64 + ch] = dg[jj];
      }
    }
    __syncthreads();
    {
      float kkw[4], kaw[4], rkw[4];
      {
        const float4 a4 = *(const float4*)(p.in[19] + hc), b4 = *(const float4*)(p.in[20] + hc), c4v = *(const float4*)(p.in[21] + hc);
        kkw[0] = a4.x; kkw[1] = a4.y; kkw[2] = a4.z; kkw[3] = a4.w;
        kaw[0] = b4.x; kaw[1] = b4.y; kaw[2] = b4.z; kaw[3] = b4.w;
        rkw[0] = c4v.x; rkw[1] = c4v.y; rkw[2] = c4v.z; rkw[3] = c4v.w;
      }
      float4 k4 = *(const float4*)(sKp + et * 64 + ec);
      float4 a4 = *(const float4*)(sKKA + et * 64 + ec);
      float4 r4 = *(const float4*)(sR + et * 64 + ec);
      float kr[4] = {k4.x, k4.y, k4.z, k4.w}, aa[4] = {a4.x, a4.y, a4.z, a4.w}, rr[4] = {r4.x, r4.y, r4.z, r4.w};
      float kk[4], ss = 0.f;
#pragma unroll
      for (int j = 0; j < 4; ++j) { kk[j] = kr[j] * kkw[j]; ss += kk[j] * kk[j]; }
      ss = row16_sum(ss);
      const float inv = fminf(__builtin_amdgcn_rsqf(ss), 1e12f);
      float kp[4], nk[4], ka[4], rk = 0.f;
#pragma unroll
      for (int j = 0; j < 4; ++j) {
        kk[j] *= inv;
        kp[j] = kr[j] * (1.f + (aa[j] - 1.f) * kaw[j]);
        nk[j] = -kk[j]; ka[j] = kk[j] * aa[j];
        rk += rr[j] * kp[j] * rkw[j];
      }
      rk = row16_sum(rk);
      *(float4*)(sKp + et * 64 + ec) = make_float4(kp[0], kp[1], kp[2], kp[3]);
      *(float4*)(sNKK + et * 64 + ec) = make_float4(nk[0], nk[1], nk[2], nk[3]);
      *(float4*)(sKKA + et * 64 + ec) = make_float4(ka[0], ka[1], ka[2], ka[3]);
      if ((tid & 15) == 0) sRK[et] = rk;
    }
    __syncthreads();
    {
      const int k = tid & 63, tq = tid >> 6;
      float gam = 1.f;
      {
        float wv[12];
#pragma unroll
        for (int t = 0; t < 12; ++t) wv[t] = sW[t * 64 + k];
#pragma unroll
        for (int t = 0; t < 12; ++t) gam *= (t < 4 * tq) ? wv[t] : 1.f;
      }
      float bt[4], kt[4];
#pragma unroll
      for (int i = 0; i < 4; ++i) {
        const int t = 4 * tq + i;
        const float gprev = gam;
        gam *= sW[t * 64 + k];
        const float ginv = frcp(gam);
        const float av = sNKK[t * 64 + k] * gprev;
        const float rv = sR[t * 64 + k] * gam;
        bt[i] = sKKA[t * 64 + k] * ginv;
        kt[i] = sKp[t * 64 + k] * ginv;
        *(u16*)(imgA + t * 144 + k * 2) = f2bf(av);
        *(u16*)(imgR + t * 144 + k * 2) = f2bf(rv);
        *(u16*)(imgB + t * 144 + k * 2) = f2bf(bt[i]);
        *(u16*)(imgK + t * 144 + k * 2) = f2bf(kt[i]);
      }
      u32x2 bv = {pack2(bt[0], bt[1]), pack2(bt[2], bt[3])};
      u32x2 kv = {pack2(kt[0], kt[1]), pack2(kt[2], kt[3])};
      *(u32x2*)(sBKT + k * 72 + tq * 8) = bv;
      *(u32x2*)(sBKT + k * 72 + 32 + tq * 8) = kv;
      if (tq == 3) sGam[k] = gam;
    }
    __syncthreads();
    {
      const unsigned char* Limg = (wave & 1) ? imgK : imgB;
      const unsigned char* Rimg = (wave & 2) ? imgR : imgA;
      f32x4 d = {0.f, 0.f, 0.f, 0.f};
#pragma unroll
      for (int ks = 0; ks < 2; ++ks) {
        bf16x8 lf = *(const bf16x8*)(Limg + r * 144 + ks * 64 + q * 16);
        bf16x8 rf = *(const bf16x8*)(Rimg + r * 144 + ks * 64 + q * 16);
        d = mfma16(lf, rf, d);
      }
      float x[4];
#pragma unroll
      for (int jj = 0; jj < 4; ++jj) {
        const int i = 4 * q + jj;
        const bool keep = (wave & 2) ? (i <= r) : (i < r);
        x[jj] = keep ? d[jj] : 0.f;
      }
      u32x2 xv = {pack2(x[0], x[1]), pack2(x[2], x[3])};
      *(u32x2*)(sMAT + wave * 640 + r * 40 + q * 8) = xv;
      if (wave == 0) {
#pragma unroll
        for (int jj = 0; jj < 4; ++jj) sNab[(4 * q + jj) * 16 + r] = x[jj];
      }
    }
    if (wave == 0) {
      float c[16];
#pragma unroll
      for (int i = 0; i < 16; ++i) c[i] = (i == r) ? 1.f : 0.f;
      int dep = 0;
#pragma unroll
      for (int ig = 14; ig >= 0; ig -= 2) {
        const float* nb = sNab + dep;
#pragma unroll
        for (int i = ig; i > ig - 2 && i >= 0; --i) {
          float acc0 = c[i], acc1 = 0.f;
#pragma unroll
          for (int j = i + 1; j < 16; ++j) { if ((j - i) & 1) acc0 += nb[i * 16 + j] * c[j]; else acc1 += nb[i * 16 + j] * c[j]; }
          c[i] = acc0 + acc1;
        }
        asm volatile("v_mov_b32 %0, 0" : "=v"(dep) : "v"(c[ig > 0 ? ig - 1 : 0]));
      }
      float tc[4];
      const float qm0 = q == 0 ? 1.f : 0.f, qm1 = q == 1 ? 1.f : 0.f, qm2 = q == 2 ? 1.f : 0.f, qm3 = q == 3 ? 1.f : 0.f;
#pragma unroll
      for (int e = 0; e < 4; ++e) tc[e] = qm0 * c[e] + qm1 * c[4 + e] + qm2 * c[8 + e] + qm3 * c[12 + e];
      { u32x2 tv = {pack2(tc[0], tc[1]), pack2(tc[2], tc[3])}; *(u32x2*)(sTT + r * 40 + q * 8) = tv; }
    }
    __syncthreads();
    if (hf == 0) {
#pragma unroll 1
      for (int cc = 0; cc < 2; ++cc) {
        if (cc == 1 && tb + 16 >= T) break;
        unsigned char* rb = smem0 + cc * 61440;
        const unsigned char* c_imgA = rb + 41216;
        const unsigned char* c_imgR = rb + 43520;
        const unsigned char* c_BKT = rb + 50432;
        const unsigned char* c_MAT = rb + 55040;
        const float* c_Gam = (const float*)(rb + 58624);
        const unsigned char* c_TT = rb + 58880;
        const float* c_V = (const float*)(rb + 20480);
        float* c_Y = (float*)(rb + 28672);
        u32x4 w;
        bf16x8 sfr[2];
#pragma unroll
        for (int ks = 0; ks < 2; ++ks) {
          w = (u32x4){pack2(S[2 * ks][0], S[2 * ks][1]), pack2(S[2 * ks][2], S[2 * ks][3]),
                      pack2(S[2 * ks + 1][0], S[2 * ks + 1][1]), pack2(S[2 * ks + 1][2], S[2 * ks + 1][3])};
          sfr[ks] = __builtin_bit_cast(bf16x8, w);
        }
        float vv[4];
#pragma unroll
        for (int e = 0; e < 4; ++e) vv[e] = c_V[(4 * q + e) * 64 + vme];
        const u32x2 vpk = {pack2(vv[0], vv[1]), pack2(vv[2], vv[3])};
        f32x4 rhs = {0.f, 0.f, 0.f, 0.f};
#pragma unroll
        for (int ks = 0; ks < 2; ++ks) {
          u32x2 lo = *(const u32x2*)(c_imgA + r * 144 + (32 * ks + 4 * q) * 2);
          u32x2 hi = *(const u32x2*)(c_imgA + r * 144 + (32 * ks + 16 + 4 * q) * 2);
          w = (u32x4){lo[0], lo[1], hi[0], hi[1]};
          rhs = mfma16(__builtin_bit_cast(bf16x8, w), sfr[ks], rhs);
        }
        {
          u32x2 nk = *(const u32x2*)(c_MAT + 1 * 640 + r * 40 + q * 8);
          w = (u32x4){nk[0], nk[1], 0u, 0u};
          u32x4 wb = {vpk[0], vpk[1], 0u, 0u};
          rhs = mfma16(__builtin_bit_cast(bf16x8, w), __builtin_bit_cast(bf16x8, wb), rhs);
        }
        f32x4 ut = {0.f, 0.f, 0.f, 0.f};
        {
          u32x2 tv = *(const u32x2*)(c_TT + r * 40 + q * 8);
          w = (u32x4){tv[0], tv[1], 0u, 0u};
          u32x4 wb = {pack2(rhs[0], rhs[1]), pack2(rhs[2], rhs[3]), 0u, 0u};
          ut = mfma16(__builtin_bit_cast(bf16x8, w), __builtin_bit_cast(bf16x8, wb), ut);
        }
        const u32x4 uvb = {pack2(ut[0], ut[1]), pack2(ut[2], ut[3]), vpk[0], vpk[1]};
        const bf16x8 uvf = __builtin_bit_cast(bf16x8, uvb);
        f32x4 yt = {0.f, 0.f, 0.f, 0.f};
#pragma unroll
        for (int ks = 0; ks < 2; ++ks) {
          u32x2 lo = *(const u32x2*)(c_imgR + r * 144 + (32 * ks + 4 * q) * 2);
          u32x2 hi = *(const u32x2*)(c_imgR + r * 144 + (32 * ks + 16 + 4 * q) * 2);
          w = (u32x4){lo[0], lo[1], hi[0], hi[1]};
          yt = mfma16(__builtin_bit_cast(bf16x8, w), sfr[ks], yt);
        }
        {
          u32x2 mb = *(const u32x2*)(c_MAT + 2 * 640 + r * 40 + q * 8);
          u32x2 mk = *(const u32x2*)(c_MAT + 3 * 640 + r * 40 + q * 8);
          w = (u32x4){mb[0], mb[1], mk[0], mk[1]};
          yt = mfma16(__builtin_bit_cast(bf16x8, w), uvf, yt);
        }
#pragma unroll
        for (int jj = 0; jj < 4; ++jj) c_Y[(4 * q + jj) * 64 + vme] = yt[jj];
#pragma unroll
        for (int g = 0; g < 4; ++g) {
          u32x2 bb = *(const u32x2*)(c_BKT + (16 * g + r) * 72 + q * 8);
          u32x2 kb = *(const u32x2*)(c_BKT + (16 * g + r) * 72 + 32 + q * 8);
          w = (u32x4){bb[0], bb[1], kb[0], kb[1]};
          f32x4 ds = {0.f, 0.f, 0.f, 0.f};
          ds = mfma16(__builtin_bit_cast(bf16x8, w), uvf, ds);
          const float4 gm = *(const float4*)(c_Gam + 16 * g + 4 * q);
          S[g][0] = (S[g][0] + ds[0]) * gm.x; S[g][1] = (S[g][1] + ds[1]) * gm.y;
          S[g][2] = (S[g][2] + ds[2]) * gm.z; S[g][3] = (S[g][3] + ds[3]) * gm.w;
        }
      }
    }
    __syncthreads();
    {
      float lnw[4], lnb[4];
      {
        const float4 a4 = *(const float4*)(p.in[22] + hc), b4 = *(const float4*)(p.in[23] + hc);
        lnw[0] = a4.x; lnw[1] = a4.y; lnw[2] = a4.z; lnw[3] = a4.w;
        lnb[0] = b4.x; lnb[1] = b4.y; lnb[2] = b4.z; lnb[3] = b4.w;
      }
      float4 y4 = *(const float4*)(sY + et * 64 + ec);
      float yy[4] = {y4.x, y4.y, y4.z, y4.w};
      float s1 = row16_sum(yy[0] + yy[1] + yy[2] + yy[3]);
      const float mean = s1 * (1.f / 64.f);
      float s2 = 0.f;
#pragma unroll
      for (int j = 0; j < 4; ++j) { yy[j] -= mean; s2 += yy[j] * yy[j]; }
      s2 = row16_sum(s2);
      const float rs = __builtin_amdgcn_rsqf(s2 * (1.f / 64.f) + 64e-5f);
      const float rk = sRK[et];
      float4 v4 = *(const float4*)(sV + et * 64 + ec);
      float4 g4 = *(const float4*)(sG + et * 64 + ec);
      const float vv[4] = {v4.x, v4.y, v4.z, v4.w}, gg[4] = {g4.x, g4.y, g4.z, g4.w};
      float o[4];
#pragma unroll
      for (int j = 0; j < 4; ++j) o[j] = (yy[j] * rs * lnw[j] + lnb[j] + rk * vv[j]) * gg[j];
      u32x2 ov = {pack2(o[0], o[1]), pack2(o[2], o[3])};
      if (t0 < T) *(u32x2*)(MIX + (size_t)(row0 + t0 + et) * 1024 + hc) = ov;
    }
    __syncthreads();
  }
  if (hf == 0) {
    float* so = is_p ? p.out + O_WKVP + ((size_t)stream * 8 + h) * 4096 : p.out + O_WKVS + ((size_t)(stream - 16) * 8 + h) * 4096;
#pragma unroll
    for (int g = 0; g < 4; ++g) *(float4*)(so + vme * 64 + g * 16 + q * 4) = make_float4(S[g][0], S[g][1], S[g][2], S[g][3]);
  }
}

__device__ __forceinline__ void phase_mix(const Params& p, unsigned char* smem, int qslot) {
  __shared__ int s_item;
  int* counter = (int*)(p.ws + WS_ZERO) + qslot;
  const int N_SCANP = 128, N_ATTS = 64, N_ATTP = 2048, N_SCANS = 64, N_ATTM = 128;
  const int total = N_SCANP + N_ATTS + N_ATTP + N_SCANS + N_ATTM;
  const u16* Q = (const u16*)(p.ws + WS_Q);
  const u16* KALL = (const u16*)(p.ws + WS_KALL);
  u16* MIX = (u16*)(p.ws + WS_MIX);
  while (true) {
    __syncthreads();
    if (threadIdx.x == 0) s_item = atomicAdd(counter, 1);
    __syncthreads();
    int it = s_item;
    if (it >= total) break;
    bool is_scan = false; int sc_stream = 0, sc_h = 0;
    AttnItem a{};
    if (it < N_SCANP) { is_scan = true; sc_stream = it >> 3; sc_h = it & 7; }
    else if (it < N_SCANP + N_ATTS) {
      it -= N_SCANP;
      const int bd = it >> 3, h = it & 7;
      a.Q = Q + (size_t)(M_P + bd * 64) * 768 + h * 96;
      a.Kb = KALL + (size_t)(M_TOT + bd * KS_S) * 768 + h * 96;
      a.Vt = (const u16*)(p.ws + WS_VTS) + ((size_t)bd * 512 + h * 64) * TPAD_S; a.ldv = TPAD_S;
      a.O = MIX + (size_t)(M_P + bd * 64) * 1024 + 512 + h * 64;
      a.nq_valid = 64; a.ntiles = 33; a.wt_base = 33; a.wt_step = 0;
    } else if (it < N_SCANP + N_ATTS + N_ATTP) {
      it -= N_SCANP + N_ATTS;
      const int j = 15 - (it >> 7), bh = it & 127, b = bh >> 3, h = bh & 7;
      const size_t qrow = (size_t)b * TP + 16 + 256 * j;
      a.Q = Q + qrow * 768 + h * 96;
      a.Kb = KALL + (size_t)b * TP * 768 + h * 96;
      a.Vt = (const u16*)(p.ws + WS_VTP) + ((size_t)b * 512 + h * 64) * TPAD_P; a.ldv = TPAD_P;
      a.O = MIX + qrow * 1024 + 512 + h * 64;
      a.nq_valid = 256; a.ntiles = 4 * j + 4; a.wt_base = 4 * j + 1; a.wt_step = 1;
    } else if (it < N_SCANP + N_ATTS + N_ATTP + N_SCANS) {
      it -= N_SCANP + N_ATTS + N_ATTP;
      is_scan = true; sc_stream = 16 + (it >> 3); sc_h = it & 7;
    } else {
      it -= N_SCANP + N_ATTS + N_ATTP + N_SCANS;
      const int b = it >> 3, h = it & 7;
      const size_t qrow = (size_t)b * TP;
      a.Q = Q + qrow * 768 + h * 96;
      a.Kb = KALL + (size_t)b * TP * 768 + h * 96;
      a.Vt = (const u16*)(p.ws + WS_VTP) + ((size_t)b * 512 + h * 64) * TPAD_P; a.ldv = TPAD_P;
      a.O = MIX + qrow * 1024 + 512 + h * 64;
      a.nq_valid = 16; a.ntiles = 0; a.wt_base = 0; a.wt_step = 0;
    }
    if (is_scan) scan_item(p, sc_stream, sc_h, smem);
    else attn_item(a, smem);
  }
}

__device__ __forceinline__ void phase_final(const Params& p) {
  const float* ssq4 = (const float*)(p.ws + WS_ZERO + 256) + 3 * (size_t)M_TOT;
  const float* gf = p.in[34];
  const int lane = threadIdx.x & 63, wave = threadIdx.x >> 6;
  const int rstride = gridDim.x * NWAVES;
  for (int orow0 = blockIdx.x * NWAVES + wave; orow0 < 65536 + 512; orow0 += 2 * rstride) {
    float* y[2]; const u16* xrow[2]; float rs[2]; bool ok[2];
#pragma unroll
    for (int u = 0; u < 2; ++u) {
      int orow = orow0 + u * rstride; ok[u] = orow < 65536 + 512; if (!ok[u]) orow = orow0;
      int row;
      if (orow < 65536) { int b = orow >> 12, f = orow & 4095; row = b * TP + 16 + f; y[u] = p.out + O_YP + (size_t)orow * 1024; }
      else { row = M_P + (orow - 65536); y[u] = p.out + O_YS + (size_t)(orow - 65536) * 1024; }
      rs[u] = rsqrtf(ssq4[row] * (1.f / 1024.f) + 1e-6f);
      xrow[u] = (const u16*)(p.ws + WS_XB) + (size_t)row * D;
    }
    u32x2 v[2][4];
#pragma unroll
    for (int u = 0; u < 2; ++u)
#pragma unroll
      for (int i = 0; i < 4; ++i) v[u][i] = *(const u32x2*)(xrow[u] + i * 256 + lane * 4);
#pragma unroll
    for (int u = 0; u < 2; ++u)
#pragma unroll
      for (int i = 0; i < 4; ++i) {
        const float4 g = *(const float4*)(gf + i * 256 + lane * 4);
        float4 t;
        t.x = bflo(v[u][i][0]) * rs[u] * g.x; t.y = bfhi(v[u][i][0]) * rs[u] * g.y;
        t.z = bflo(v[u][i][1]) * rs[u] * g.z; t.w = bfhi(v[u][i][1]) * rs[u] * g.w;
        if (ok[u]) *(float4*)(y[u] + i * 256 + lane * 4) = t;
      }
  }
}

__device__ __forceinline__ void run_phase(const Params& p, int ph, unsigned char* smem, int qslot, const XcdInfo xi) {
  float* ssq = (float*)(p.ws + WS_ZERO + 256);
  u16* XB = (u16*)(p.ws + WS_XB);
  u16* ACT = (u16*)(p.ws + WS_ACT);
  switch (ph) {
#if PH_ON(0)
    case 0: phase_prep(p, smem); break;
#endif
#if PH_ON(1)
    case 1: {
      GemmArgs g{XB, D, (const u16*)(p.ws + WS_W13A), D, D};
      EpiArgs e{}; e.ssq_in = ssq; e.dst = ACT; e.ldd = DFF;
      gemm_phase<EPI_FFNUP, 8>(g, e, 256, 22, smem, xi, NCH_UP);
      gemm_phase<EPI_FFNUP, 4>(g, e, 6, 22, smem, xi, NCH_UP, 65536);
    } break;
#endif
#if PH_ON(2)
    case 2: {
      GemmArgs g{ACT, DFF, (const u16*)(p.ws + WS_W2A), DFF, DFF};
      EpiArgs e{}; e.ssq_out = ssq + M_TOT; e.dst = XB; e.ldd = D; e.alpha = 0.5f;
      gemm_phase<EPI_RESID, 8>(g, e, 256, 4, smem, xi, NCH_DOWN);
      gemm_phase<EPI_RESID, 4>(g, e, 6, 4, smem, xi, NCH_DOWN, 65536);
    } break;
#endif
#if PH_ON(3)
    case 3: {
      GemmArgs g{XB, D, (const u16*)(p.ws + WS_WIN), D, D};
      EpiArgs e{}; e.ssq_in = ssq + M_TOT; e.dst = (u16*)(p.ws + WS_P); e.ldd = NIN; e.out = p.out;
      gemm_phase<EPI_WIN, 8>(g, e, 256, 9, smem, xi, NCH_WIN);
      gemm_phase<EPI_WIN, 4>(g, e, 6, 9, smem, xi, NCH_WIN, 65536);
    } break;
#endif
#if PH_ON(4)
    case 4: phase_mla_prep(p); break;
#endif
#if PH_ON(5)
    case 5: phase_mla_gemms(p, smem); break;
#endif
#if PH_ON(6)
    case 6: phase_mix(p, smem, qslot); break;
#endif
#if PH_ON(7)
    case 7: {
      GemmArgs g{(const u16*)(p.ws + WS_MIX), D, (const u16*)(p.ws + WS_WOUT), D, D};
      EpiArgs e{}; e.ssq_out = ssq + 2 * (size_t)M_TOT; e.dst = XB; e.ldd = D; e.alpha = 1.f;
      gemm_phase<EPI_RESID, 8>(g, e, 256, 4, smem, xi, NCH_OUT);
      gemm_phase<EPI_RESID, 4>(g, e, 6, 4, smem, xi, NCH_OUT, 65536);
    } break;
#endif
#if PH_ON(8)
    case 8: {
      GemmArgs g{XB, D, (const u16*)(p.ws + WS_W13B), D, D};
      EpiArgs e{}; e.ssq_in = ssq + 2 * (size_t)M_TOT; e.dst = ACT; e.ldd = DFF;
      gemm_phase<EPI_FFNUP, 8>(g, e, 256, 22, smem, xi, NCH_UP);
      gemm_phase<EPI_FFNUP, 4>(g, e, 6, 22, smem, xi, NCH_UP, 65536);
    } break;
#endif
#if PH_ON(9)
    case 9: {
      GemmArgs g{ACT, DFF, (const u16*)(p.ws + WS_W2B), DFF, DFF};
      EpiArgs e{}; e.ssq_out = ssq + 3 * (size_t)M_TOT; e.dst = XB; e.ldd = D; e.alpha = 0.5f; e.out = p.out;
      gemm_phase<EPI_RESID, 8>(g, e, 256, 4, smem, xi, NCH_DOWN);
      gemm_phase<EPI_RESID, 4>(g, e, 6, 4, smem, xi, NCH_DOWN, 65536);
    } break;
#endif
#if PH_ON(10)
    case 10: phase_final(p); break;
#endif
  }
}


#define XB_TMO      128
#define XB_XCNT(j)  (256  + 64 * (j))
#define XB_XSUB(j)  (1280 + 64 * (j))
#define XB_XGEN(j)  (2304 + 64 * (j))
#define XB_TOP      3328
#define XB_TOPGEN   3392
#define XB_SPIN_CAP (1u << 20)
#define LAS __attribute__((address_space(3)))
__device__ __forceinline__ unsigned xb_ld(unsigned* p)              { return __hip_atomic_load(p, __ATOMIC_RELAXED, __HIP_MEMORY_SCOPE_AGENT); }
__device__ __forceinline__ unsigned xb_add(unsigned* p, unsigned v) { return __hip_atomic_fetch_add(p, v, __ATOMIC_RELAXED, __HIP_MEMORY_SCOPE_AGENT); }
__device__ __forceinline__ unsigned xb_xcc_id() { return (unsigned)__builtin_amdgcn_s_getreg((3 << 11) | 20) & 0xFu; }
#define XB_SPIN(cond, bar) do { unsigned _sp = 0; while (cond) { __builtin_amdgcn_s_sleep(1); \
    if ((++_sp & 255u) == 0u) { if (xb_ld(&(bar)[XB_TMO])) break; if (_sp > XB_SPIN_CAP) { atomicAdd(&(bar)[XB_TMO], 1u); break; } } } } while (0)
struct XcdBarrier { unsigned* bar; unsigned x; volatile LAS unsigned* st; };
__device__ __forceinline__ XcdBarrier xcd_barrier_post(unsigned* bar, volatile LAS unsigned* st) {
    XcdBarrier b; b.bar = bar; b.x = xb_xcc_id(); b.st = st;
    if (threadIdx.x == 0) (void)xb_add(&bar[XB_XCNT(b.x)], 1u);
    return b;
}
__device__ __forceinline__ void xcd_barrier_complete(unsigned* bar, unsigned x, unsigned& nloc, unsigned& nx) {
    const unsigned G = gridDim.x * gridDim.y * gridDim.z;
    unsigned sum, cnt, mine, sp = 0u;
    for (;;) {
        sum = 0u; cnt = 0u; mine = 0u;
#pragma unroll
        for (unsigned j = 0; j < 16; ++j) { const unsigned c = xb_ld(&bar[XB_XCNT(j)]); sum += c; cnt += (c > 0u) ? 1u : 0u; mine = (j == x) ? c : mine; }
        if (sum == G) break;
        __builtin_amdgcn_s_sleep(1);
        if ((++sp & 255u) == 0u) { if (xb_ld(&bar[XB_TMO])) break; if (sp > XB_SPIN_CAP) { atomicAdd(&bar[XB_TMO], 1u); break; } }
    }
    nloc = mine > 0u ? mine : 1u; nx = cnt > 0u ? cnt : 1u;
}
__device__ __forceinline__ void xcd_barrier(const XcdBarrier& b) {
    asm volatile("s_waitcnt vmcnt(0)" ::: "memory");
    __syncthreads();
    if (threadIdx.x == 0) {
        unsigned* bar = b.bar;
        __builtin_amdgcn_s_waitcnt(0);
        unsigned nloc = b.st[0], nx = b.st[1];
        if (nloc == 0u) { xcd_barrier_complete(bar, b.x, nloc, nx); b.st[0] = nloc; b.st[1] = nx; }
        const unsigned old = xb_add(&bar[XB_XSUB(b.x)], 1u);
        const unsigned gen = old / nloc;
        if (old + 1u == (gen + 1u) * nloc) {
            __builtin_amdgcn_fence(__ATOMIC_RELEASE, "agent");
            asm volatile("s_waitcnt vmcnt(0)" ::: "memory");
            const unsigned og = xb_add(&bar[XB_TOP], 1u);
            const unsigned tg = og / nx;
            if (og + 1u == (tg + 1u) * nx) xb_add(&bar[XB_TOPGEN], 1u);
            else XB_SPIN(xb_ld(&bar[XB_TOPGEN]) == tg, bar);
            __builtin_amdgcn_fence(__ATOMIC_ACQUIRE, "agent");
            xb_add(&bar[XB_XGEN(b.x)], 1u);
            asm volatile("s_waitcnt vmcnt(0)" ::: "memory");
        } else {
            XB_SPIN(xb_ld(&bar[XB_XGEN(b.x)]) == gen, bar);
            __builtin_amdgcn_fence(__ATOMIC_ACQUIRE, "agent");
            asm volatile("s_waitcnt vmcnt(0)" ::: "memory");
        }
    }
    __syncthreads();
}

__global__ void __launch_bounds__(NTHREADS, 2) mega(Params p, int ph_lo, int ph_hi) {
  __shared__ __attribute__((aligned(16))) unsigned char smem[SMEM_BYTES];
  cg::grid_group grid = cg::this_grid();
  __shared__ int s_xi[2];
  int* xcnt = (int*)(p.ws + WS_ZERO) + 16;
  if (threadIdx.x == 0) {
    const int xcc = __builtin_amdgcn_s_getreg(0x1814) & 7;
    s_xi[0] = xcc;
    s_xi[1] = atomicAdd(xcnt + xcc, 1);
  }
  XcdInfo xi{(int)(blockIdx.x & 7), (int)(blockIdx.x >> 3), (gridDim.x & 7) == 0 ? (int)(gridDim.x >> 3) : 0};
  __shared__ __attribute__((aligned(16))) unsigned xb_words[4];
  if (threadIdx.x == 0) { xb_words[0] = 0u; xb_words[1] = 0u; }
  __syncthreads();
  const XcdBarrier xb = xcd_barrier_post((unsigned*)(p.ws + WS_XBAR), (volatile LAS unsigned*)&xb_words);
  if (ph_hi == 0x7fffffff) grid.sync();
#ifndef PROBE_DBL
#define PROBE_DBL 0
#endif
#define RUN_PH(X) if (ph_lo <= X && X <= ph_hi) { if ((PROBE_DBL >> X) & 1) { run_phase(p, X, smem, 1, xi); grid.sync(); } run_phase(p, X, smem, 0, xi); if (X < ph_hi) xcd_barrier(xb); }
  RUN_PH(0)
  if (ph_lo == 0 && ph_hi > 0) {
    int c0 = __hip_atomic_load(xcnt, __ATOMIC_RELAXED, __HIP_MEMORY_SCOPE_AGENT);
    bool even = c0 > 0 && c0 * 8 == (int)gridDim.x;
#pragma unroll
    for (int i = 1; i < 8; ++i) even = even && (__hip_atomic_load(xcnt + i, __ATOMIC_RELAXED, __HIP_MEMORY_SCOPE_AGENT) == c0);
    if (even) { xi.xcd = s_xi[0]; xi.slot = s_xi[1]; xi.nbx = c0; }
  }
  RUN_PH(1) RUN_PH(2) RUN_PH(3) RUN_PH(4) RUN_PH(5) RUN_PH(6) RUN_PH(7) RUN_PH(8) RUN_PH(9) RUN_PH(10)
}

extern "C" void kernel_launch(void* const* d_in, const int* in_sizes, int n_in, void* d_out, int out_size,
                              void* d_ws, size_t ws_size, hipStream_t stream) {
  static int grid_blocks = 0;
  if (!grid_blocks) {
    int dev = 0, cus = 0, per_cu = 0;
    hipGetDevice(&dev);
    hipDeviceGetAttribute(&cus, hipDeviceAttributeMultiprocessorCount, dev);
    hipOccupancyMaxActiveBlocksPerMultiprocessor(&per_cu, mega, NTHREADS, 0);
    if (per_cu > 1) per_cu = 1;
    if (per_cu < 1) per_cu = 1;
    grid_blocks = cus * per_cu;
  }
  Params p{};
  for (int i = 0; i < 35; ++i) p.in[i] = (const float*)d_in[i];
  p.out = (float*)d_out;
  p.ws = (unsigned char*)d_ws;
  hipMemsetAsync((unsigned char*)d_ws + WS_ZERO, 0, ZERO_BYTES, stream);
#if ONE_LAUNCH
  int lo = 0, hi = 10;
  void* args[] = {&p, &lo, &hi};
  hipError_t e = hipLaunchCooperativeKernel((void*)mega, dim3(grid_blocks), dim3(NTHREADS), args, 0, stream);
  if (e != hipSuccess) fprintf(stderr, "cooperative launch failed: %s (grid %d)\n", hipGetErrorString(e), grid_blocks);
#else
  for (int ph = 0; ph <= 10; ++ph) {
    int lo = ph, hi = ph;
    void* args[] = {&p, &lo, &hi};
    hipError_t e = hipLaunchCooperativeKernel((void*)mega, dim3(grid_blocks), dim3(NTHREADS), args, 0, stream);
    if (e != hipSuccess) fprintf(stderr, "cooperative launch failed: %s (grid %d)\n", hipGetErrorString(e), grid_blocks);
  }
#endif
}
```

```cpp
#include <hip/hip_runtime.h>
#include <hip/hip_cooperative_groups.h>
#include <cstdio>
#include <type_traits>
namespace cg = cooperative_groups;

typedef unsigned short u16;
typedef unsigned int u32;
using bf16x8 = __attribute__((ext_vector_type(8))) short;
using f32x4 = __attribute__((ext_vector_type(4))) float;
using u32x4 = __attribute__((ext_vector_type(4))) unsigned;
using u32x2 = __attribute__((ext_vector_type(2))) unsigned;
#define DI __device__ __forceinline__

#ifndef PHASE_MASK
#define PHASE_MASK 0x7ff
#endif
#define PH_ON(x) ((PHASE_MASK >> (x)) & 1)
#ifndef NCH_UP
#define NCH_UP 4
#endif
#ifndef NCH_DOWN
#define NCH_DOWN 0
#endif
#ifndef NCH_WIN
#define NCH_WIN 2
#endif
#ifndef NCH_OUT
#define NCH_OUT 0
#endif
#ifndef RES_MF
#define RES_MF 8
#endif
#ifndef ONE_LAUNCH
#define ONE_LAUNCH 1
#endif

constexpr int D = 1024;
constexpr int TP = 4112;
constexpr int M_P = 16 * TP;
constexpr int M_TOT = M_P + 512;
constexpr int DFF = 2816;
constexpr int NIN = 2208;
constexpr int NINP = 2304;
constexpr int KS_S = 2128;
constexpr int KS_TOT = M_TOT + 8 * KS_S;
constexpr int KS_ALLOC = 326 * 256 + 256;
constexpr int TPAD_P = 4352;
constexpr int TPAD_S = 2304;
constexpr int NTHREADS = 512;
constexpr int NWAVES = 8;

constexpr long O_YP = 0;
constexpr long O_YS = O_YP + 16L * 4096 * 1024;
constexpr long O_CKVP = O_YS + 8L * 64 * 1024;
constexpr long O_KRP = O_CKVP + 16L * TP * 128;
constexpr long O_WKVP = O_KRP + 16L * TP * 32;
constexpr long O_SHP = O_WKVP + 16L * 8 * 64 * 64;
constexpr long O_CKVS = O_SHP + 16L * 1792;
constexpr long O_KRS = O_CKVS + 8L * 64 * 128;
constexpr long O_WKVS = O_KRS + 8L * 64 * 32;
constexpr long O_SHS = O_WKVS + 8L * 8 * 64 * 64;

constexpr size_t al256(size_t x) { return (x + 255) & ~size_t(255); }
constexpr size_t WS_ZERO = 0;
constexpr size_t WS_XBAR = WS_ZERO + 256 + 4 * (size_t)M_TOT * 4;
constexpr size_t ZERO_BYTES = al256(256 + 4 * (size_t)M_TOT * 4 + 3456 * 4);
constexpr size_t WS_ROPE = WS_ZERO + ZERO_BYTES;
constexpr size_t WS_W13A = WS_ROPE + al256((size_t)TP * 16 * 8);
constexpr size_t WS_W2A = WS_W13A + (size_t)2 * DFF * D * 2;
constexpr size_t WS_WIN = WS_W2A + (size_t)D * DFF * 2;
constexpr size_t WS_WOUT = WS_WIN + (size_t)NINP * D * 2;
constexpr size_t WS_W13B = WS_WOUT + (size_t)D * D * 2;
constexpr size_t WS_W2B = WS_W13B + (size_t)2 * DFF * D * 2;
constexpr size_t WS_WQ = WS_W2B + (size_t)D * DFF * 2;
constexpr size_t WS_WUK = WS_WQ + (size_t)768 * 256 * 2;
constexpr size_t WS_WUV = WS_WUK + (size_t)512 * 128 * 2;
constexpr size_t WS_WW2 = WS_WUV + (size_t)512 * 128 * 2;
constexpr size_t WS_WA2 = WS_WW2 + (size_t)512 * 64 * 2;
constexpr size_t WS_WG2 = WS_WA2 + (size_t)512 * 64 * 2;
constexpr size_t WS_XB = al256(WS_WG2 + (size_t)512 * 128 * 2);
constexpr size_t WS_ACT = WS_XB + (size_t)M_TOT * D * 2;
constexpr size_t ACT_BYTES = (size_t)M_TOT * DFF * 2;
constexpr size_t WS_P = WS_ACT + ACT_BYTES;
constexpr size_t WS_MIX = WS_P + al256((size_t)M_TOT * NIN * 2);
constexpr size_t WS_CQN = WS_MIX + (size_t)M_TOT * D * 2;
constexpr size_t WS_CB = WS_CQN + (size_t)M_TOT * 256 * 2;
constexpr size_t WS_END = WS_CB + (size_t)KS_ALLOC * 128 * 2;
constexpr size_t WS_Q = WS_ACT;
constexpr size_t WS_KALL = WS_Q + (size_t)M_TOT * 768 * 2;
constexpr size_t WS_VTP = WS_KALL + (size_t)KS_ALLOC * 768 * 2;
constexpr size_t WS_VTS = WS_VTP + (size_t)16 * 512 * TPAD_P * 2;
constexpr size_t WS_ALIAS_END = WS_VTS + (size_t)8 * 512 * TPAD_S * 2;
static_assert(WS_ALIAS_END <= WS_ACT + ACT_BYTES, "alias region overflow");
static_assert(WS_END <= (size_t)1 << 30, "workspace too large");

constexpr int SMEM_BYTES = 131072;

struct Params {
  const float* in[35];
  float* out;
  unsigned char* ws;
};

DI u32 pack2(float a, float b);
DI u16 f2bf(float f) { return (u16)(pack2(f, 0.f) & 0xffffu); }
DI float bf2f(u16 h) { return __uint_as_float(((u32)h) << 16); }
typedef float f32x2_t __attribute__((ext_vector_type(2)));
typedef __bf16 bf16x2_t __attribute__((ext_vector_type(2)));
DI u32 pack2(float a, float b) {
  f32x2_t v = {a, b};
  bf16x2_t r = __builtin_convertvector(v, bf16x2_t);
  return __builtin_bit_cast(u32, r);
}
DI float bflo(u32 v) { return __uint_as_float(v << 16); }
DI float bfhi(u32 v) { return __uint_as_float(v & 0xffff0000u); }
DI float wave_sum(float v) {
#pragma unroll
  for (int o = 32; o >= 1; o >>= 1) v += __shfl_xor(v, o);
  return v;
}
template <int CTRL> DI float dpp_f(float v) {
  return __int_as_float(__builtin_amdgcn_update_dpp(0, __float_as_int(v), CTRL, 0xf, 0xf, false));
}
DI float row16_sum(float v) {
  v += dpp_f<0xB1>(v);
  v += dpp_f<0x4E>(v);
  v += dpp_f<0x141>(v);
  v += dpp_f<0x140>(v);
  return v;
}
DI float frcp(float x) { return __builtin_amdgcn_rcpf(x); }
DI float sigmoidf_(float x) { return frcp(1.f + __expf(-x)); }
DI float siluf_(float x) { return x * frcp(1.f + __expf(-x)); }
DI int row_pos(int row) { return row < M_P ? row % TP : 2064 + ((row - M_P) & 63); }
DI int swz(int r, int c4) { return r * 64 + ((c4 ^ ((r >> 3) << 1)) << 4); }
DI f32x4 mfma16(bf16x8 a, bf16x8 b, f32x4 c) { return __builtin_amdgcn_mfma_f32_16x16x32_bf16(a, b, c, 0, 0, 0); }

struct TJob { const float* src; int K, N, Npad; size_t dst; const float* gain; float scale; int mode; };
DI void transpose_tile(const Params& p, const TJob& j, int kt, int nt, float* sm, bool active) {
  const float* src = j.src;
  const float* gain = j.gain;
  u16* dst = (u16*)(p.ws + j.dst);
  const int tid = threadIdx.x & 255;
  sm += (threadIdx.x >> 8) * (64 * 65);
  __syncthreads();
  if (active) {
#pragma unroll
  for (int i = 0; i < 16; ++i) {
    int idx = tid + i * 256;
    int kk = idx >> 6, nn = idx & 63;
    int k = kt * 64 + kk, n = nt * 64 + nn;
    float v = 0.f;
    if (n < j.N) {
      v = src[(size_t)k * j.N + n] * j.scale;
      if (gain) v *= gain[k];
    }
    sm[kk * 65 + nn] = v;
  }
  }
  __syncthreads();
  if (active) {
    int nn = tid >> 2, kq = (tid & 3) * 16;
    int n = nt * 64 + nn;
    int drow = n;
    if (j.mode == 3) {
      const int c = n & 63;
      drow = (n & ~63) + 16 * ((c & 15) >> 2) + 4 * (c >> 4) + (c & 3);
    } else if (j.mode) {
      const int a = n & 31;
      drow = ((n >> 5) << 6) + ((((a & 7) >> 2) * 2 + (j.mode == 2 ? 1 : 0)) << 4) + 4 * (a >> 3) + (a & 3);
    }
    u32 w[8];
#pragma unroll
    for (int i = 0; i < 8; ++i) w[i] = pack2(sm[(kq + 2 * i) * 65 + nn], sm[(kq + 2 * i + 1) * 65 + nn]);
    u32x4* d = (u32x4*)(dst + (size_t)drow * j.K + kt * 64 + kq);
    u32x4 a = {w[0], w[1], w[2], w[3]}, b = {w[4], w[5], w[6], w[7]};
    d[0] = a; d[1] = b;
  }
}

__device__ __forceinline__ void phase_prep(const Params& p, unsigned char* smem) {
  float* sm = (float*)smem;
  const float qs = 0.10206207261596577f * 1.4426950408889634f;
  auto get_job = [&](int ji) -> TJob {
    switch (ji) {
      case 0: return TJob{p.in[8], D, DFF, DFF, WS_W13A, p.in[7], 1.f, 1};
      case 1: return TJob{p.in[9], D, DFF, DFF, WS_W13A, p.in[7], 1.f, 2};
      case 2: return TJob{p.in[10], DFF, D, D, WS_W2A, nullptr, 1.f, 3};
      case 3: return TJob{p.in[12], D, NIN, NINP, WS_WIN, p.in[11], 1.f, 3};
      case 4: return TJob{p.in[29], D, D, D, WS_WOUT, nullptr, 1.f, 3};
      case 5: return TJob{p.in[31], D, DFF, DFF, WS_W13B, p.in[30], 1.f, 1};
      case 6: return TJob{p.in[32], D, DFF, DFF, WS_W13B, p.in[30], 1.f, 2};
      case 7: return TJob{p.in[33], DFF, D, D, WS_W2B, nullptr, 1.f, 3};
      case 8: return TJob{p.in[25], 256, 768, 768, WS_WQ, p.in[24], qs, 0};
      case 9: return TJob{p.in[27], 128, 512, 512, WS_WUK, nullptr, 1.f, 3};
      case 10: return TJob{p.in[28], 128, 512, 512, WS_WUV, nullptr, 1.f, 0};
      case 11: return TJob{p.in[15], 64, 512, 512, WS_WW2, nullptr, 1.f, 0};
      case 12: return TJob{p.in[17], 64, 512, 512, WS_WA2, nullptr, 1.f, 0};
      default: return TJob{p.in[18], 128, 512, 512, WS_WG2, nullptr, 1.f, 0};
    }
  };
  auto do_tiles = [&]() {
  int base = 0;
#pragma unroll 1
  for (int ji = 0; ji < 14; ++ji) {
    const TJob j = get_job(ji);
    int nkt = j.K / 64, nnt = j.Npad / 64;
    int cnt = nkt * nnt;
    int first = ((int)blockIdx.x - base % (int)gridDim.x + (int)gridDim.x) % (int)gridDim.x;
    for (int t = first; t < cnt; t += 2 * gridDim.x) {
      const int tt = t + (int)(threadIdx.x >> 8) * (int)gridDim.x;
      transpose_tile(p, j, tt % nkt, tt / nkt, sm, tt < cnt);
    }
    base += cnt;
  }
  };
  auto do_x = [&]() {
  {
    u16* xb = (u16*)(p.ws + WS_XB);
    float* ssq1 = (float*)(p.ws + WS_ZERO + 256);
    const int lane = threadIdx.x & 63, wave = threadIdx.x >> 6;
    const int rstride = gridDim.x * NWAVES;
    for (int row = blockIdx.x * NWAVES + wave; row < M_TOT; row += 2 * rstride) {
      const float* src[2]; int rows[2]; bool ok[2];
#pragma unroll
      for (int u = 0; u < 2; ++u) {
        int rw = row + u * rstride; ok[u] = rw < M_TOT; if (!ok[u]) rw = row; rows[u] = rw;
        if (rw < M_P) {
          int b = rw / TP, pp = rw % TP;
          src[u] = pp < 16 ? p.in[6] + (size_t)pp * D : p.in[0] + ((size_t)b * 4096 + (pp - 16)) * D;
        } else src[u] = p.in[1] + (size_t)(rw - M_P) * D;
      }
      float4 v[2][4];
#pragma unroll
      for (int u = 0; u < 2; ++u)
#pragma unroll
        for (int i = 0; i < 4; ++i) v[u][i] = *(const float4*)(src[u] + i * 256 + lane * 4);
#pragma unroll
      for (int u = 0; u < 2; ++u) {
        float sacc = 0.f;
#pragma unroll
        for (int i = 0; i < 4; ++i) {
          const float4 t = v[u][i];
          sacc += t.x * t.x + t.y * t.y + t.z * t.z + t.w * t.w;
          u32x2 o = {pack2(t.x, t.y), pack2(t.z, t.w)};
          if (ok[u]) *(u32x2*)(xb + (size_t)rows[u] * D + i * 256 + lane * 4) = o;
        }
        sacc = wave_sum(sacc);
        if (lane == 0 && ok[u]) ssq1[rows[u]] = sacc;
      }
    }
  }
  };
  if (blockIdx.x & 1) { do_x(); do_tiles(); } else { do_tiles(); do_x(); }
  {
    float2* rt = (float2*)(p.ws + WS_ROPE);
    for (int i = blockIdx.x * NTHREADS + threadIdx.x; i < TP * 16; i += gridDim.x * NTHREADS) {
      int pos = i >> 4, f = i & 15;
      float inv = exp2f(-(float)f * (13.287712379549449f / 16.f));
      float ang = (float)pos * inv;
      float rev = ang * 0.15915494309189535f;
      rev = rev - rintf(rev);
      rt[i] = make_float2(__builtin_amdgcn_cosf(rev), __builtin_amdgcn_sinf(rev));
    }
  }
}

struct GemmArgs { const u16* A; long lda; const u16* B; long ldb; int K; };
enum { EPI_FFNUP = 0, EPI_RESID = 1, EPI_WIN = 2, EPI_FINAL = 3, EPI_Q = 4, EPI_KN = 5, EPI_VT = 6 };
struct EpiArgs {
  const float* ssq_in;
  float* ssq_out;
  u16* dst; long ldd;
  float alpha;
  float* out;
  const float2* rope;
  int rows_valid;
};

template <int EPI, int MF>
__device__ __forceinline__ void gemm_tile(const GemmArgs g, const int m0, const int n0, unsigned char* smem, const EpiArgs e,
                                          const bool preloaded = false, const bool has_next = false, const int nm0 = 0, const int nn0 = 0) {
  const int tid = threadIdx.x, lane = tid & 63, wave = tid >> 6;
  const int wm = wave >> 2, wn = wave & 3, r = lane & 15, q = lane >> 4;
  f32x4 acc[MF][4];
#pragma unroll
  for (int m = 0; m < MF; ++m)
#pragma unroll
    for (int n = 0; n < 4; ++n) acc[m][n] = (f32x4){0.f, 0.f, 0.f, 0.f};
  constexpr int APW = MF / 2;
  const int pr = lane >> 3, pc = (lane & 7) ^ (lane >> 3);
  const u16* ag = g.A + (size_t)(m0 + wave * (APW * 8) + pr) * g.lda + pc * 8;
  const u16* bg = g.B + (size_t)(n0 + wave * 32 + pr) * g.ldb + pc * 8;
  const int rr = r & 7;
  const int lbase = ((r >> 3) << 10) + (rr << 7);
  const int lofs0 = lbase + ((q ^ rr) << 4), lofs1 = lbase + (((4 + q) ^ rr) << 4);
  typedef void __attribute__((address_space(3))) * lds_ptr;
  const unsigned lds_base = (unsigned)(unsigned long)((lds_ptr)smem);
  const int nk = g.K >> 6;
  if (!preloaded) __syncthreads();
#define GEMM_PIECE_A(BUF, I) __builtin_amdgcn_global_load_lds((const void*)(ag + (size_t)(I) * 8 * g.lda), (lds_ptr)(smem + (BUF) * 65536 + (wave * APW + (I)) * 1024 + lane * 16), 16, 0, 0)
#define GEMM_PIECE_B(BUF, I) __builtin_amdgcn_global_load_lds((const void*)(bg + (size_t)(I) * 8 * g.ldb), (lds_ptr)(smem + (BUF) * 65536 + 32768 + (wave * 4 + (I)) * 1024 + lane * 16), 16, 0, 0)
#define GEMM_STAGE(BUF)                                                    \
  do {                                                                     \
    _Pragma("unroll") for (int i = 0; i < APW; ++i) GEMM_PIECE_A(BUF, i);  \
    _Pragma("unroll") for (int i = 0; i < 4; ++i) GEMM_PIECE_B(BUF, i);    \
    ag += 64; bg += 64;                                                    \
  } while (0)
#define GEMM_WAIT0 asm volatile("s_waitcnt vmcnt(0)\n\ts_barrier" ::: "memory")
  if (preloaded) { ag += 64; bg += 64; }
  else GEMM_STAGE(0);
  GEMM_WAIT0;
  int buf = 0;
#pragma unroll 1
  for (int kt = 0; kt < nk; ++kt) {
    const bool issue = kt + 1 < nk;
    const int ibuf = buf ^ 1;
#pragma unroll
    for (int s2 = 0; s2 < 2; ++s2) {
      bf16x8 bf[4], af[MF];
      {
        const unsigned la = lds_base + buf * 65536 + ((wm * MF) << 11) + (s2 ? lofs1 : lofs0);
        const unsigned lb = lds_base + buf * 65536 + 32768 + ((wn * 4) << 11) + (s2 ? lofs1 : lofs0);
        if constexpr (MF == 8) {
          asm volatile(
              "ds_read_b128 %0, %13\n\tds_read_b128 %1, %13 offset:2048\n\tds_read_b128 %2, %13 offset:4096\n\tds_read_b128 %3, %13 offset:6144\n\t"
              "ds_read_b128 %4, %12\n\tds_read_b128 %5, %12 offset:2048\n\tds_read_b128 %6, %12 offset:4096\n\tds_read_b128 %7, %12 offset:6144\n\t"
              "ds_read_b128 %8, %12 offset:8192\n\tds_read_b128 %9, %12 offset:10240\n\tds_read_b128 %10, %12 offset:12288\n\tds_read_b128 %11, %12 offset:14336\n\t"
              "s_waitcnt lgkmcnt(0)"
              : "=&v"(bf[0]), "=&v"(bf[1]), "=&v"(bf[2]), "=&v"(bf[3]), "=&v"(af[0]), "=&v"(af[1]), "=&v"(af[2]), "=&v"(af[3]),
                "=&v"(af[4]), "=&v"(af[5]), "=&v"(af[6]), "=&v"(af[7])
              : "v"(la), "v"(lb)
              : "memory");
        } else {
          asm volatile(
              "ds_read_b128 %0, %9\n\tds_read_b128 %1, %9 offset:2048\n\tds_read_b128 %2, %9 offset:4096\n\tds_read_b128 %3, %9 offset:6144\n\t"
              "ds_read_b128 %4, %8\n\tds_read_b128 %5, %8 offset:2048\n\tds_read_b128 %6, %8 offset:4096\n\tds_read_b128 %7, %8 offset:6144\n\t"
              "s_waitcnt lgkmcnt(0)"
              : "=&v"(bf[0]), "=&v"(bf[1]), "=&v"(bf[2]), "=&v"(bf[3]), "=&v"(af[0]), "=&v"(af[1]), "=&v"(af[2]), "=&v"(af[3])
              : "v"(la), "v"(lb)
              : "memory");
        }
      }
      __builtin_amdgcn_sched_barrier(0);
      __builtin_amdgcn_s_setprio(1);
#pragma unroll
      for (int m = 0; m < MF; ++m) {
#pragma unroll
        for (int n = 0; n < 4; ++n) acc[m][n] = mfma16(bf[n], af[m], acc[m][n]);
        if constexpr (MF == 8) {
          if (m & 1) {
            __builtin_amdgcn_sched_barrier(0);
            if (issue) {
              if (s2 == 0) { if (m == 1) GEMM_PIECE_A(ibuf, 0); if (m == 3) GEMM_PIECE_A(ibuf, 1); if (m == 5) GEMM_PIECE_A(ibuf, 2); if (m == 7) GEMM_PIECE_A(ibuf, 3); }
              else { if (m == 1) GEMM_PIECE_B(ibuf, 0); if (m == 3) GEMM_PIECE_B(ibuf, 1); if (m == 5) GEMM_PIECE_B(ibuf, 2); if (m == 7) GEMM_PIECE_B(ibuf, 3); }
            }
            __builtin_amdgcn_sched_barrier(0);
          }
        } else {
          if (m < 3) {
            __builtin_amdgcn_sched_barrier(0);
            if (issue) {
              if (s2 == 0) { if (m == 0) GEMM_PIECE_A(ibuf, 0); if (m == 1) GEMM_PIECE_A(ibuf, 1); if (m == 2) GEMM_PIECE_B(ibuf, 0); }
              else { if (m == 0) GEMM_PIECE_B(ibuf, 1); if (m == 1) GEMM_PIECE_B(ibuf, 2); if (m == 2) GEMM_PIECE_B(ibuf, 3); }
            }
            __builtin_amdgcn_sched_barrier(0);
          }
        }
      }
      __builtin_amdgcn_s_setprio(0);
      __builtin_amdgcn_sched_barrier(0);
    }
    if (issue) { ag += 64; bg += 64; }
    GEMM_WAIT0;
    buf ^= 1;
  }
  const int rbase = m0 + wm * (MF * 16) + r;
  const int cbase = n0 + wn * 64 + q * 4;
  const int cb16 = n0 + wn * 64 + q * 16;
  float rsv[MF];
  constexpr bool PRE_X = (EPI == EPI_RESID || EPI == EPI_FINAL) && MF == 4;
  float xv[PRE_X ? MF : 1][16];
  if constexpr (EPI == EPI_FFNUP || EPI == EPI_WIN) {
#pragma unroll
    for (int m = 0; m < MF; ++m) rsv[m] = rsqrtf(e.ssq_in[rbase + m * 16] * (1.f / 1024.f) + 1e-6f);
  }
  if constexpr (PRE_X) {
    u32x4 xin[MF][2];
#pragma unroll
    for (int m = 0; m < MF; ++m) {
      const u16* xp = e.dst + (size_t)(rbase + m * 16) * e.ldd + cb16;
      xin[m][0] = *(const u32x4*)xp; xin[m][1] = *(const u32x4*)(xp + 8);
    }
#pragma unroll
    for (int m = 0; m < MF; ++m) {
#pragma unroll
      for (int i = 0; i < 4; ++i) {
        xv[m][2 * i] = bflo(xin[m][0][i]); xv[m][2 * i + 1] = bfhi(xin[m][0][i]);
        xv[m][8 + 2 * i] = bflo(xin[m][1][i]); xv[m][8 + 2 * i + 1] = bfhi(xin[m][1][i]);
      }
#pragma unroll
      for (int n = 0; n < 4; ++n)
#pragma unroll
        for (int j = 0; j < 4; ++j) xv[m][4 * n + j] += e.alpha * acc[m][n][j];
    }
  }
  if constexpr (EPI == EPI_FFNUP || EPI == EPI_WIN) {
#pragma unroll
    for (int m = 0; m < MF; ++m) asm volatile("" :: "v"(rsv[m]));
  }
  if constexpr (PRE_X) {
#pragma unroll
    for (int m = 0; m < MF; ++m)
      asm volatile("" :: "v"(xv[m][0]), "v"(xv[m][1]), "v"(xv[m][2]), "v"(xv[m][3]), "v"(xv[m][4]), "v"(xv[m][5]), "v"(xv[m][6]), "v"(xv[m][7]),
                   "v"(xv[m][8]), "v"(xv[m][9]), "v"(xv[m][10]), "v"(xv[m][11]), "v"(xv[m][12]), "v"(xv[m][13]), "v"(xv[m][14]), "v"(xv[m][15]));
  }
  __builtin_amdgcn_sched_barrier(0);
  if (has_next) {
    ag = g.A + (size_t)(nm0 + wave * (APW * 8) + pr) * g.lda + pc * 8;
    bg = g.B + (size_t)(nn0 + wave * 32 + pr) * g.ldb + pc * 8;
    GEMM_STAGE(0);
  }
  __builtin_amdgcn_sched_barrier(0);
#undef GEMM_STAGE
#undef GEMM_WAIT0
#undef GEMM_PIECE_A
#undef GEMM_PIECE_B
  if constexpr (EPI == EPI_FFNUP) {
#pragma unroll
    for (int m = 0; m < MF; ++m) {
      const int row = rbase + m * 16;
      const float rs = rsv[m];
      const int col = ((n0 + wn * 64) >> 1) + q * 8;
      float o[8];
#pragma unroll
      for (int pr = 0; pr < 2; ++pr)
#pragma unroll
        for (int j = 0; j < 4; ++j) o[pr * 4 + j] = siluf_(acc[m][2 * pr][j] * rs) * (acc[m][2 * pr + 1][j] * rs);
      u32x4 v = {pack2(o[0], o[1]), pack2(o[2], o[3]), pack2(o[4], o[5]), pack2(o[6], o[7])};
      *(u32x4*)(e.dst + (size_t)row * e.ldd + col) = v;
    }
  } else if constexpr (EPI == EPI_RESID || EPI == EPI_FINAL) {
#pragma unroll
    for (int m = 0; m < MF; ++m) {
      const int row = rbase + m * 16;
      float ss = 0.f;
      float* yrow = nullptr;
      if constexpr (EPI == EPI_FINAL) {
        if (row < M_P) {
          int b = row / TP, pp = row % TP;
          if (pp >= 16) yrow = e.out + O_YP + ((size_t)b * 4096 + (pp - 16)) * 1024;
        } else yrow = e.out + O_YS + (size_t)(row - M_P) * 1024;
      }
      u16* xp = e.dst + (size_t)row * e.ldd + cb16;
      float x[16];
      if constexpr (PRE_X) {
#pragma unroll
        for (int i = 0; i < 16; ++i) x[i] = xv[m][i];
      } else {
        const u32x4 xa = *(const u32x4*)xp, xb = *(const u32x4*)(xp + 8);
#pragma unroll
        for (int i = 0; i < 4; ++i) {
          x[2 * i] = bflo(xa[i]); x[2 * i + 1] = bfhi(xa[i]);
          x[8 + 2 * i] = bflo(xb[i]); x[8 + 2 * i + 1] = bfhi(xb[i]);
        }
#pragma unroll
        for (int n = 0; n < 4; ++n)
#pragma unroll
          for (int j = 0; j < 4; ++j) x[4 * n + j] += e.alpha * acc[m][n][j];
      }
      if constexpr (EPI == EPI_RESID) {
        u32x4 va = {pack2(x[0], x[1]), pack2(x[2], x[3]), pack2(x[4], x[5]), pack2(x[6], x[7])};
        u32x4 vb = {pack2(x[8], x[9]), pack2(x[10], x[11]), pack2(x[12], x[13]), pack2(x[14], x[15])};
        *(u32x4*)xp = va; *(u32x4*)(xp + 8) = vb;
#pragma unroll
        for (int i = 0; i < 4; ++i) {
          x[2 * i] = bflo(va[i]); x[2 * i + 1] = bfhi(va[i]);
          x[8 + 2 * i] = bflo(vb[i]); x[8 + 2 * i + 1] = bfhi(vb[i]);
        }
      } else {
        if (yrow) {
#pragma unroll
          for (int i = 0; i < 4; ++i) *(float4*)(yrow + cb16 + 4 * i) = make_float4(x[4 * i], x[4 * i + 1], x[4 * i + 2], x[4 * i + 3]);
        }
      }
#pragma unroll
      for (int i = 0; i < 16; ++i) ss += x[i] * x[i];
      ss += __shfl_xor(ss, 16);
      ss += __shfl_xor(ss, 32);
      if (q == 0) atomicAdd(e.ssq_out + row, ss);
    }
  } else if constexpr (EPI == EPI_WIN) {
#pragma unroll
    for (int m = 0; m < MF; ++m) {
      const int row = rbase + m * 16;
      const float rs = rsv[m];
      float* sh = nullptr;
      if (row < M_P) { if (row % TP == TP - 1) sh = e.out + O_SHP + (size_t)(row / TP) * 1792; }
      else if (((row - M_P) & 63) == 63) sh = e.out + O_SHS + (size_t)((row - M_P) >> 6) * 1792;
      if (cb16 < NIN) {
        float x[16];
#pragma unroll
        for (int n = 0; n < 4; ++n)
#pragma unroll
          for (int j = 0; j < 4; ++j) x[4 * n + j] = acc[m][n][j] * rs;
        u32x4 va = {pack2(x[0], x[1]), pack2(x[2], x[3]), pack2(x[4], x[5]), pack2(x[6], x[7])};
        u32x4 vb = {pack2(x[8], x[9]), pack2(x[10], x[11]), pack2(x[12], x[13]), pack2(x[14], x[15])};
        u16* dp = e.dst + (size_t)row * e.ldd + cb16;
        *(u32x4*)dp = va; *(u32x4*)(dp + 8) = vb;
        if (sh && cb16 < 1792) {
#pragma unroll
          for (int i = 0; i < 4; ++i) *(float4*)(sh + cb16 + 4 * i) = make_float4(x[4 * i], x[4 * i + 1], x[4 * i + 2], x[4 * i + 3]);
        }
      }
    }
  } else if constexpr (EPI == EPI_Q) {
#pragma unroll
    for (int m = 0; m < MF; ++m) {
      const int row = rbase + m * 16;
      const int pos = row_pos(row);
#pragma unroll
      for (int n = 0; n < 4; ++n) {
        const int col = cbase + n * 16;
        const int hc = col % 96;
        float v0 = acc[m][n][0], v1 = acc[m][n][1], v2 = acc[m][n][2], v3 = acc[m][n][3];
        if (hc >= 64) {
          const int f0 = (hc - 64) & 15;
          const float4 cs01 = *(const float4*)(e.rope + pos * 16 + f0);
          const float4 cs23 = *(const float4*)(e.rope + pos * 16 + f0 + 2);
          if (hc < 80) {
            if (n < 3) {
              const f32x4 o = acc[m][n < 3 ? n + 1 : n];
              v0 = v0 * cs01.x - o[0] * cs01.y; v1 = v1 * cs01.z - o[1] * cs01.w;
              v2 = v2 * cs23.x - o[2] * cs23.y; v3 = v3 * cs23.z - o[3] * cs23.w;
            }
          } else {
            if (n > 0) {
              const f32x4 o = acc[m][n > 0 ? n - 1 : n];
              v0 = o[0] * cs01.y + v0 * cs01.x; v1 = o[1] * cs01.w + v1 * cs01.z;
              v2 = o[2] * cs23.y + v2 * cs23.x; v3 = o[3] * cs23.w + v3 * cs23.z;
            }
          }
        }
        u32x2 v = {pack2(v0, v1), pack2(v2, v3)};
        *(u32x2*)(e.dst + (size_t)row * e.ldd + col) = v;
      }
    }
  } else if constexpr (EPI == EPI_KN) {
#pragma unroll
    for (int m = 0; m < MF; ++m) {
      const int row = rbase + m * 16;
      if (row < e.rows_valid) {
        const int h = cb16 >> 6, d = cb16 & 63;
        u32x4 va = {pack2(acc[m][0][0], acc[m][0][1]), pack2(acc[m][0][2], acc[m][0][3]), pack2(acc[m][1][0], acc[m][1][1]), pack2(acc[m][1][2], acc[m][1][3])};
        u32x4 vb = {pack2(acc[m][2][0], acc[m][2][1]), pack2(acc[m][2][2], acc[m][2][3]), pack2(acc[m][3][0], acc[m][3][1]), pack2(acc[m][3][2], acc[m][3][3])};
        u16* dp = e.dst + (size_t)row * 768 + h * 96 + d;
        *(u32x4*)dp = va; *(u32x4*)(dp + 8) = vb;
      }
    }
  } else if constexpr (EPI == EPI_VT) {
#pragma unroll
    for (int m = 0; m < MF; ++m) {
      const int row = rbase + m * 16;
#pragma unroll
      for (int n = 0; n < 4; ++n) {
        const int col = cbase + n * 16;
        u32x2 v = {pack2(acc[m][n][0], acc[m][n][1]), pack2(acc[m][n][2], acc[m][n][3])};
        *(u32x2*)(e.dst + (size_t)row * e.ldd + col) = v;
      }
    }
  }
}

struct XcdInfo { int xcd, slot, nbx; };
template <int EPI, int MF>
__device__ __forceinline__ void gemm_phase(const GemmArgs g, const EpiArgs e, int mtiles, int ntiles, unsigned char* smem, const XcdInfo xi, const int nchunk, const int m_base = 0) {
  const int nb = gridDim.x;
  constexpr int BM = MF * 32;
  const bool can_pre = !((EPI == EPI_RESID || EPI == EPI_FINAL) && MF == 8);
  if (xi.nbx > 0) {
    const int xcd = xi.xcd, slot = xi.slot, nbx = xi.nbx;
    const int mloc = (mtiles + 7) >> 3;
    constexpr int GS = 2;
    const int mgroups = (mloc + GS - 1) / GS;
    const int total = nchunk == 0 ? mgroups * GS * ntiles : mloc * ntiles;
    auto decode = [&](int L, int& m, int& n) {
      if (nchunk == 0) {
        const int mg = L / (GS * ntiles), rem = L % (GS * ntiles);
        m = (mg * GS + (rem & (GS - 1))) * 8 + xcd; n = rem / GS;
      } else {
        int c = 0;
#pragma unroll
        for (int cc = 1; cc < 4; ++cc) if (cc < nchunk && L >= mloc * ((cc * ntiles) / nchunk)) c = cc;
        const int ns = (c * ntiles) / nchunk, ne = ((c + 1) * ntiles) / nchunk, cn = ne - ns;
        const int rem = L - mloc * ns;
        m = (rem / cn) * 8 + xcd; n = ns + rem % cn;
      }
    };
    auto tile_m = [&](int L) { int m, n; decode(L, m, n); return m; };
    auto tile_n = [&](int L) { int m, n; decode(L, m, n); return n; };
    auto next_valid = [&](int L) { while (L < total && tile_m(L) >= mtiles) L += nbx; return L; };
    int L = next_valid(slot);
    bool pre = false;
    while (L < total) {
      const int Ln = next_valid(L + nbx);
      const bool hn = can_pre && Ln < total;
      gemm_tile<EPI, MF>(g, m_base + tile_m(L) * BM, tile_n(L) * 256, smem, e, pre, hn, hn ? m_base + tile_m(Ln) * BM : 0, hn ? tile_n(Ln) * 256 : 0);
      pre = hn; L = Ln;
    }
  } else {
    const int total = mtiles * ntiles;
    int t = blockIdx.x;
    bool pre = false;
    while (t < total) {
      const int tn = t + nb;
      const bool hn = can_pre && tn < total;
      gemm_tile<EPI, MF>(g, m_base + (t / ntiles) * BM, (t % ntiles) * 256, smem, e, pre, hn, hn ? m_base + (tn / ntiles) * BM : 0, hn ? (tn % ntiles) * 256 : 0);
      pre = hn; t = tn;
    }
  }
}

__device__ __forceinline__ void phase_mla_prep(const Params& p) {
  const u16* P = (const u16*)(p.ws + WS_P);
  u16* CQN = (u16*)(p.ws + WS_CQN);
  u16* CB = (u16*)(p.ws + WS_CB);
  u16* KALL = (u16*)(p.ws + WS_KALL);
  const float2* rope = (const float2*)(p.ws + WS_ROPE);
  const float* gkv = p.in[26];
  const int lane = threadIdx.x & 63, wave = threadIdx.x >> 6;
  const float g0 = gkv[lane * 2], g1 = gkv[lane * 2 + 1];
  const int rstride = gridDim.x * NWAVES;
  for (int row0 = blockIdx.x * NWAVES + wave; row0 < KS_TOT; row0 += 2 * rstride) {
    int rows[2], prow[2], pos[2]; bool ok[2];
    u32x2 qv[2]; u32 cv[2]; float x1[2], x2[2]; float2 cs[2]; float cf0[2], cf1[2], kf0[2], kf1[2];
#pragma unroll
    for (int u = 0; u < 2; ++u) {
      int row = row0 + u * rstride; ok[u] = row < KS_TOT; if (!ok[u]) row = row0; rows[u] = row;
      prow[u] = -1; pos[u] = 0; int cache_idx = 0;
      if (row < M_TOT) { prow[u] = row; pos[u] = row_pos(row); }
      else {
        int sr = row - M_TOT, bd = sr / KS_S, idx = sr % KS_S;
        pos[u] = idx;
        if (idx < 16) prow[u] = idx;
        else if (idx >= 2064) prow[u] = M_P + bd * 64 + (idx - 2064);
        else cache_idx = bd * 2048 + (idx - 16);
      }
      qv[u] = (u32x2){0u, 0u}; cv[u] = 0u; x1[u] = x2[u] = 0.f; cs[u] = make_float2(1.f, 0.f); cf0[u] = cf1[u] = kf0[u] = kf1[u] = 0.f;
      if (prow[u] >= 0) {
        const u16* pr = P + (size_t)prow[u] * NIN;
        if (row < M_TOT) qv[u] = *(const u32x2*)(pr + 1792 + lane * 4);
        cv[u] = *(const u32*)(pr + 2048 + lane * 2);
        if (lane < 16) { x1[u] = bf2f(pr[2176 + lane]); x2[u] = bf2f(pr[2176 + 16 + lane]); cs[u] = rope[pos[u] * 16 + lane]; }
      } else {
        const float* cc = p.in[2] + (size_t)cache_idx * 128;
        cf0[u] = cc[lane * 2]; cf1[u] = cc[lane * 2 + 1];
        if (lane < 16) { const float* kr = p.in[3] + (size_t)cache_idx * 32; kf0[u] = kr[lane]; kf1[u] = kr[lane + 16]; }
      }
    }
#pragma unroll
    for (int u = 0; u < 2; ++u) {
      const int row = rows[u];
      float c0, c1, k0 = 0.f, k1 = 0.f;
      if (prow[u] >= 0) {
        if (row < M_TOT) {
          float a0 = bflo(qv[u][0]), a1 = bfhi(qv[u][0]), a2 = bflo(qv[u][1]), a3 = bfhi(qv[u][1]);
          float s = wave_sum(a0 * a0 + a1 * a1 + a2 * a2 + a3 * a3);
          float rs = rsqrtf(s * (1.f / 256.f) + 1e-6f);
          u32x2 o = {pack2(a0 * rs, a1 * rs), pack2(a2 * rs, a3 * rs)};
          if (ok[u]) *(u32x2*)(CQN + (size_t)row * 256 + lane * 4) = o;
        }
        c0 = bflo(cv[u]); c1 = bfhi(cv[u]);
        float s = wave_sum(c0 * c0 + c1 * c1);
        float rs = rsqrtf(s * (1.f / 128.f) + 1e-6f);
        c0 = c0 * rs * g0; c1 = c1 * rs * g1;
        if (lane < 16) { k0 = x1[u] * cs[u].x - x2[u] * cs[u].y; k1 = x1[u] * cs[u].y + x2[u] * cs[u].x; }
      } else {
        c0 = cf0[u]; c1 = cf1[u]; k0 = kf0[u]; k1 = kf1[u];
      }
      if (ok[u]) {
        *(u32*)(CB + (size_t)row * 128 + lane * 2) = pack2(c0, c1);
        if (lane < 16) {
          u16 b0 = f2bf(k0), b1 = f2bf(k1);
#pragma unroll
          for (int h = 0; h < 8; ++h) {
            KALL[(size_t)row * 768 + h * 96 + 64 + lane] = b0;
            KALL[(size_t)row * 768 + h * 96 + 80 + lane] = b1;
          }
        }
        if (row < M_TOT) {
          float* oc; float* okp;
          if (row < M_P) { oc = p.out + O_CKVP + (size_t)row * 128; okp = p.out + O_KRP + (size_t)row * 32; }
          else { oc = p.out + O_CKVS + (size_t)(row - M_P) * 128; okp = p.out + O_KRS + (size_t)(row - M_P) * 32; }
          *(float2*)(oc + lane * 2) = make_float2(c0, c1);
          if (lane < 16) { okp[lane] = k0; okp[lane + 16] = k1; }
        }
      }
    }
  }
}

__device__ __forceinline__ void phase_mla_gemms(const Params& p, unsigned char* smem) {
  const int T_Q = 259 * 3, T_K = 326 * 2, T_VP = 16 * 2 * 17, T_VS = 8 * 2 * 9;
  const int total = T_Q + T_K + T_VP + T_VS;
  for (int t = blockIdx.x; t < total; t += gridDim.x) {
    if (t < T_Q) {
      GemmArgs g{(const u16*)(p.ws + WS_CQN), 256, (const u16*)(p.ws + WS_WQ), 256, 256};
      EpiArgs e{}; e.dst = (u16*)(p.ws + WS_Q); e.ldd = 768; e.rope = (const float2*)(p.ws + WS_ROPE);
      gemm_tile<EPI_Q, 8>(g, (t / 3) * 256, (t % 3) * 256, smem, e);
    } else if (t < T_Q + T_K) {
      int u = t - T_Q;
      GemmArgs g{(const u16*)(p.ws + WS_CB), 128, (const u16*)(p.ws + WS_WUK), 128, 128};
      EpiArgs e{}; e.dst = (u16*)(p.ws + WS_KALL); e.rows_valid = KS_TOT;
      gemm_tile<EPI_KN, 8>(g, (u >> 1) * 256, (u & 1) * 256, smem, e);
    } else {
      int u = t - T_Q - T_K;
      int s, mt, nt; long rowbase; u16* dst; long ldd;
      if (u < T_VP) { s = u / 34; int v = u % 34; mt = v / 17; nt = v % 17; rowbase = (long)s * TP;
        dst = (u16*)(p.ws + WS_VTP) + (size_t)s * 512 * TPAD_P; ldd = TPAD_P; }
      else { u -= T_VP; s = u / 18; int v = u % 18; mt = v / 9; nt = v % 9; rowbase = (long)M_TOT + (long)s * KS_S;
        dst = (u16*)(p.ws + WS_VTS) + (size_t)s * 512 * TPAD_S; ldd = TPAD_S; }
      GemmArgs g{(const u16*)(p.ws + WS_WUV), 128, (const u16*)(p.ws + WS_CB) + rowbase * 128, 128, 128};
      EpiArgs e{}; e.dst = dst; e.ldd = ldd;
      gemm_tile<EPI_VT, 8>(g, mt * 256, nt * 256, smem, e);
    }
  }
}

DI int vswz(int r, int c4) { return r * 64 + ((c4 ^ (r >> 2)) << 4); }

struct AttnItem {
  const u16* Q; const u16* Kb; const u16* Vt; long ldv;
  u16* O; int nq_valid; int ntiles;
  int wt_base, wt_step;
};

__device__ __forceinline__ void attn_item(const AttnItem it, unsigned char* smem) {
  int tid = threadIdx.x;
  asm volatile("" : "+v"(tid));
  const int lane = tid & 63, wave = tid >> 6;
  const int r = lane & 15, q = lane >> 4;
  const int my_tiles = it.wt_base + (wave >> 1) * it.wt_step;
  bf16x8 qf[2][3];
#pragma unroll
  for (int f = 0; f < 2; ++f) {
    int qr = wave * 32 + f * 16 + r;
    if (qr >= it.nq_valid) qr = it.nq_valid - 1;
#pragma unroll
    for (int ks = 0; ks < 3; ++ks) qf[f][ks] = *(const bf16x8*)(it.Q + (size_t)qr * 768 + ks * 32 + q * 8);
  }
  f32x4 o[4][2];
#pragma unroll
  for (int d = 0; d < 4; ++d)
#pragma unroll
    for (int f = 0; f < 2; ++f) o[d][f] = (f32x4){0.f, 0.f, 0.f, 0.f};
  float mrun[2] = {-1e30f, -1e30f}, lrun[2] = {0.f, 0.f};
  u32x4 rk[2], rv;
  int kofs[2], vofs;
  const u16* kptr[2]; const u16* vptr;
  const bool k2 = tid < 256;
#pragma unroll
  for (int i = 0; i < 2; ++i) {
    int c = tid + i * 512; if (c >= 768) c = 767; int key = c / 12, kc = c % 12;
    kptr[i] = it.Kb + (size_t)key * 768 + kc * 8;
    kofs[i] = (((key >> 4) * 3 + (kc >> 2)) << 10) + swz(key & 15, kc & 3);
  }
  {
    int c = tid; int dv = c >> 3, kc = c & 7;
    vptr = it.Vt + (size_t)dv * it.ldv + kc * 8;
    vofs = (((dv >> 4) * 2 + (kc >> 2)) << 10) + vswz(dv & 15, kc & 3);
  }
  const int nt_all = it.ntiles + 1;
  rk[0] = *(const u32x4*)(kptr[0]);
  rk[1] = *(const u32x4*)(kptr[1]);
  rv = *(const u32x4*)(vptr);
  __syncthreads();
  {
    unsigned char* sK = smem; unsigned char* sV = smem + 12288;
    *(u32x4*)(sK + kofs[0]) = rk[0];
    if (k2) *(u32x4*)(sK + kofs[1]) = rk[1];
    *(u32x4*)(sV + vofs) = rv;
  }
  __syncthreads();
  auto tile_body = [&](auto meta_tag, const unsigned char* sK, const unsigned char* sV) {
    constexpr bool META = decltype(meta_tag)::value;
    constexpr int NKF = META ? 1 : 4;
    constexpr int NKS = META ? 1 : 2;
    f32x4 s[NKF][2];
#pragma unroll
    for (int kf = 0; kf < NKF; ++kf)
#pragma unroll
      for (int f = 0; f < 2; ++f) s[kf][f] = (f32x4){0.f, 0.f, 0.f, 0.f};
#pragma unroll
    for (int kf = 0; kf < NKF; ++kf) {
#pragma unroll
      for (int ks = 0; ks < 3; ++ks) {
        bf16x8 kfr = *(const bf16x8*)(sK + ((kf * 3 + ks) << 10) + swz(r, q));
#pragma unroll
        for (int f = 0; f < 2; ++f) s[kf][f] = mfma16(kfr, qf[f][ks], s[kf][f]);
      }
    }
    float mx[2];
#pragma unroll
    for (int f = 0; f < 2; ++f) {
      float m_ = s[0][f][0];
#pragma unroll
      for (int kf = 0; kf < NKF; ++kf)
#pragma unroll
        for (int j = 0; j < 4; ++j) m_ = fmaxf(m_, s[kf][f][j]);
      m_ = fmaxf(m_, __shfl_xor(m_, 16));
      m_ = fmaxf(m_, __shfl_xor(m_, 32));
      mx[f] = m_;
    }
    const bool need = (mx[0] > mrun[0] + 8.f) || (mx[1] > mrun[1] + 8.f);
    if (__builtin_amdgcn_ballot_w64(need) != 0ull) {
#pragma unroll
      for (int f = 0; f < 2; ++f) {
        const float mnew = fmaxf(mrun[f], mx[f]);
        const float alpha = __builtin_amdgcn_exp2f(mrun[f] - mnew);
        mrun[f] = mnew;
        lrun[f] *= alpha;
#pragma unroll
        for (int d = 0; d < 4; ++d)
#pragma unroll
          for (int j = 0; j < 4; ++j) o[d][f][j] *= alpha;
      }
    }
    bf16x8 pf[2][NKS];
#pragma unroll
    for (int f = 0; f < 2; ++f) {
      float pv[NKF][4];
      float ps = 0.f;
#pragma unroll
      for (int kf = 0; kf < NKF; ++kf)
#pragma unroll
        for (int j = 0; j < 4; ++j) { pv[kf][j] = __builtin_amdgcn_exp2f(s[kf][f][j] - mrun[f]); ps += pv[kf][j]; }
      lrun[f] += ps;
      if constexpr (META) {
        u32x4 w = {pack2(pv[0][0], pv[0][1]), pack2(pv[0][2], pv[0][3]), 0u, 0u};
        pf[f][0] = __builtin_bit_cast(bf16x8, w);
      } else {
#pragma unroll
        for (int ks = 0; ks < 2; ++ks) {
          u32x4 w = {pack2(pv[2 * ks][0], pv[2 * ks][1]), pack2(pv[2 * ks][2], pv[2 * ks][3]),
                     pack2(pv[2 * ks + 1][0], pv[2 * ks + 1][1]), pack2(pv[2 * ks + 1][2], pv[2 * ks + 1][3])};
          pf[f][ks] = __builtin_bit_cast(bf16x8, w);
        }
      }
    }
#pragma unroll
    for (int ks = 0; ks < NKS; ++ks) {
#pragma unroll
      for (int d = 0; d < 4; ++d) {
        const unsigned char* vb = sV + ((d * 2 + ks) << 10) + r * 64;
        const int x = (r >> 2) << 1;
        u32x2 lo = *(const u32x2*)(vb + (((q) ^ x) << 3));
        u32x2 hi = *(const u32x2*)(vb + (((4 + q) ^ x) << 3));
        u32x4 w = {lo[0], lo[1], hi[0], hi[1]};
        bf16x8 vf = __builtin_bit_cast(bf16x8, w);
#pragma unroll
        for (int f = 0; f < 2; ++f) o[d][f] = mfma16(vf, pf[f][ks], o[d][f]);
      }
    }
  };
#pragma unroll 1
  for (int ti = 0; ti < nt_all; ++ti) {
    unsigned char* sK = smem + (ti & 1) * 20480; unsigned char* sV = sK + 12288;
    if (ti + 1 < nt_all) {
      const long koff = 16 + 64 * (long)ti;
      rk[0] = *(const u32x4*)(kptr[0] + koff * 768);
      rk[1] = *(const u32x4*)(kptr[1] + koff * 768);
      rv = *(const u32x4*)(vptr + koff);
    }
    if (ti == 0) tile_body(std::true_type{}, sK, sV);
    else if (ti <= my_tiles) tile_body(std::false_type{}, sK, sV);
    if (ti + 1 < nt_all) {
      unsigned char* nK = smem + ((ti + 1) & 1) * 20480; unsigned char* nV = nK + 12288;
      *(u32x4*)(nK + kofs[0]) = rk[0];
      if (k2) *(u32x4*)(nK + kofs[1]) = rk[1];
      *(u32x4*)(nV + vofs) = rv;
    }
    __syncthreads();
  }
#pragma unroll
  for (int f = 0; f < 2; ++f) {
    float l = lrun[f];
    l += __shfl_xor(l, 16);
    l += __shfl_xor(l, 32);
    const float inv = 1.f / l;
    const int qr = wave * 32 + f * 16 + r;
    if (qr < it.nq_valid) {
#pragma unroll
      for (int d = 0; d < 4; ++d) {
        u32x2 v = {pack2(o[d][f][0] * inv, o[d][f][1] * inv), pack2(o[d][f][2] * inv, o[d][f][3] * inv)};
        *(u32x2*)(it.O + (size_t)qr * 1024 + d * 16 + q * 4) = v;
      }
    }
  }
}

__device__ __forceinline__ void scan_item(const Params& p, int stream, int h, unsigned char* smem) {
  int tid = threadIdx.x;
  asm volatile("" : "+v"(tid));
  const int hf = tid >> 8;
  unsigned char* const smem0 = smem;
  smem += hf * 61440;
  tid &= 255;
  const int lane = tid & 63, wave = tid >> 6;
  const int r = lane & 15, q = lane >> 4;
  const bool is_p = stream < 16;
  const int T = is_p ? TP : 64;
  const long row0 = is_p ? (long)stream * TP : (long)M_P + (long)(stream - 16) * 64;
  const u16* P = (const u16*)(p.ws + WS_P);
  u16* MIX = (u16*)(p.ws + WS_MIX);
  const float* mu = p.in[13];
  const float* shift0 = is_p ? nullptr : p.in[5] + (size_t)(stream - 16) * 1792;
  float* sW = (float*)smem;
  float* sKp = sW + 1024;
  float* sNKK = sKp + 1024;
  float* sKKA = sNKK + 1024;
  float* sR = sKKA + 1024;
  float* sV = sR + 1024;
  float* sG = sV + 1024;
  float* sY = sG + 1024;
  float* sRK = sY + 1024;
  unsigned char* sTW = (unsigned char*)(sRK + 64);
  unsigned char* sAL = sTW + 2048;
  unsigned char* sSG = sAL + 2048;
  unsigned char* imgA = sSG + 4096;
  unsigned char* imgR = imgA + 2304;
  unsigned char* imgB = imgR + 2304;
  unsigned char* imgK = imgB + 2304;
  unsigned char* sBKT = imgK + 2304;
  unsigned char* sMAT = sBKT + 4608;
  float* sNab = (float*)(sMAT + 2560);
  float* sGam = sNab + 256;
  unsigned char* sTT = (unsigned char*)(sGam + 64);
  const int chw = h * 64 + wave * 16 + r;
  bf16x8 bw[2], ba[2], bg[4];
  {
    const u16* Ww = (const u16*)(p.ws + WS_WW2) + (size_t)chw * 64;
    const u16* Wa = (const u16*)(p.ws + WS_WA2) + (size_t)chw * 64;
    const u16* Wg = (const u16*)(p.ws + WS_WG2) + (size_t)chw * 128;
#pragma unroll
    for (int ks = 0; ks < 2; ++ks) { bw[ks] = *(const bf16x8*)(Ww + ks * 32 + q * 8); ba[ks] = *(const bf16x8*)(Wa + ks * 32 + q * 8); }
#pragma unroll
    for (int ks = 0; ks < 4; ++ks) bg[ks] = *(const bf16x8*)(Wg + ks * 32 + q * 8);
  }
  const float w0c = p.in[14][chw], a0c = p.in[16][chw];
  const int et = tid >> 4, ec = (tid & 15) * 4;
  const int hc = h * 64 + ec;
  const int lseg = (tid & 15) * 16;
  float S[4][4];
  const int vme = wave * 16 + r;
  if (is_p) {
#pragma unroll
    for (int g = 0; g < 4; ++g)
#pragma unroll
      for (int j = 0; j < 4; ++j) S[g][j] = 0.f;
  } else {
    const float* st = p.in[4] + ((size_t)(stream - 16) * 8 + h) * 4096;
#pragma unroll
    for (int g = 0; g < 4; ++g) {
      float4 v = *(const float4*)(st + vme * 64 + g * 16 + q * 4);
      S[g][0] = v.x; S[g][1] = v.y; S[g][2] = v.z; S[g][3] = v.w;
    }
  }
  u32x2 g_cr, g_pr, g_ck, g_pk, g_cv, g_pv;
  u32x4 g_cl0, g_cl1, g_pl0, g_pl1;
#define SCAN_LOAD(T0)                                                              \
  do {                                                                             \
    long _row = row0 + (T0) + et; if (_row > M_TOT - 1) _row = M_TOT - 1;          \
    long _prow = _row > 0 ? _row - 1 : 0;                                          \
    const u16* _pc = P + (size_t)_row * NIN; const u16* _pp = P + (size_t)_prow * NIN; \
    g_cr = *(const u32x2*)(_pc + hc); g_pr = *(const u32x2*)(_pp + hc);            \
    g_ck = *(const u32x2*)(_pc + 512 + hc); g_pk = *(const u32x2*)(_pp + 512 + hc); \
    g_cv = *(const u32x2*)(_pc + 1024 + hc); g_pv = *(const u32x2*)(_pp + 1024 + hc); \
    g_cl0 = *(const u32x4*)(_pc + 1536 + lseg); g_cl1 = *(const u32x4*)(_pc + 1536 + lseg + 8); \
    g_pl0 = *(const u32x4*)(_pp + 1536 + lseg); g_pl1 = *(const u32x4*)(_pp + 1536 + lseg + 8); \
  } while (0)
  SCAN_LOAD(16 * hf);
  __syncthreads();
#pragma unroll 1
  for (int tb = 0; tb < T; tb += 32) {
    const int t0 = tb + 16 * hf;
    {
      float mu_r[4], mu_k[4], mu_v[4];
      {
        const float4 a4 = *(const float4*)(mu + hc), b4 = *(const float4*)(mu + 512 + hc), c4v = *(const float4*)(mu + 1024 + hc);
        mu_r[0] = a4.x; mu_r[1] = a4.y; mu_r[2] = a4.z; mu_r[3] = a4.w;
        mu_k[0] = b4.x; mu_k[1] = b4.y; mu_k[2] = b4.z; mu_k[3] = b4.w;
        mu_v[0] = c4v.x; mu_v[1] = c4v.y; mu_v[2] = c4v.z; mu_v[3] = c4v.w;
      }
      const bool first = (t0 + et) == 0;
      float rr[4], kk_[4], vv[4];
      {
        u32x2 c = g_cr, pv = first ? (u32x2){0u, 0u} : g_pr;
        float cf[4] = {bflo(c[0]), bfhi(c[0]), bflo(c[1]), bfhi(c[1])};
        float pf[4] = {bflo(pv[0]), bfhi(pv[0]), bflo(pv[1]), bfhi(pv[1])};
        if (first && shift0) { float4 s4 = *(const float4*)(shift0 + hc); pf[0] = s4.x; pf[1] = s4.y; pf[2] = s4.z; pf[3] = s4.w; }
#pragma unroll
        for (int j = 0; j < 4; ++j) rr[j] = cf[j] + mu_r[j] * (pf[j] - cf[j]);
      }
      {
        u32x2 c = g_ck, pv = first ? (u32x2){0u, 0u} : g_pk;
        float cf[4] = {bflo(c[0]), bfhi(c[0]), bflo(c[1]), bfhi(c[1])};
        float pf[4] = {bflo(pv[0]), bfhi(pv[0]), bflo(pv[1]), bfhi(pv[1])};
        if (first && shift0) { float4 s4 = *(const float4*)(shift0 + 512 + hc); pf[0] = s4.x; pf[1] = s4.y; pf[2] = s4.z; pf[3] = s4.w; }
#pragma unroll
        for (int j = 0; j < 4; ++j) kk_[j] = cf[j] + mu_k[j] * (pf[j] - cf[j]);
      }
      {
        u32x2 c = g_cv, pv = first ? (u32x2){0u, 0u} : g_pv;
        float cf[4] = {bflo(c[0]), bfhi(c[0]), bflo(c[1]), bfhi(c[1])};
        float pf[4] = {bflo(pv[0]), bfhi(pv[0]), bflo(pv[1]), bfhi(pv[1])};
        if (first && shift0) { float4 s4 = *(const float4*)(shift0 + 1024 + hc); pf[0] = s4.x; pf[1] = s4.y; pf[2] = s4.z; pf[3] = s4.w; }
#pragma unroll
        for (int j = 0; j < 4; ++j) vv[j] = cf[j] + mu_v[j] * (pf[j] - cf[j]);
      }
      *(float4*)(sR + et * 64 + ec) = make_float4(rr[0], rr[1], rr[2], rr[3]);
      *(float4*)(sKp + et * 64 + ec) = make_float4(kk_[0], kk_[1], kk_[2], kk_[3]);
      *(float4*)(sV + et * 64 + ec) = make_float4(vv[0], vv[1], vv[2], vv[3]);
      {
        unsigned char* base; int kcol;
        if (lseg < 64) { base = sTW; kcol = lseg; }
        else if (lseg < 128) { base = sAL; kcol = lseg - 64; }
        else { base = sSG; kcol = lseg - 128; }
        const int st = kcol >> 5, c4 = (kcol & 31) >> 3;
#pragma unroll
        for (int hf = 0; hf < 2; ++hf) {
          const u32x4 cc = hf ? g_cl1 : g_cl0;
          u32x4 pq = {0u, 0u, 0u, 0u};
          if (!first) pq = hf ? g_pl1 : g_pl0;
          float cf[8], pf[8], lv[8];
#pragma unroll
          for (int j = 0; j < 4; ++j) {
            cf[2 * j] = bflo(cc[j]); cf[2 * j + 1] = bfhi(cc[j]);
            pf[2 * j] = bflo(pq[j]); pf[2 * j + 1] = bfhi(pq[j]);
          }
          if (first && shift0) {
#pragma unroll
            for (int j = 0; j < 8; ++j) pf[j] = shift0[1536 + lseg + hf * 8 + j];
          }
          const float4 m0 = *(const float4*)(mu + 1536 + lseg + hf * 8), m1 = *(const float4*)(mu + 1536 + lseg + hf * 8 + 4);
          const float mul[8] = {m0.x, m0.y, m0.z, m0.w, m1.x, m1.y, m1.z, m1.w};
          const float act_s = lseg < 64 ? 2.f : 1.f;
#pragma unroll
          for (int j = 0; j < 8; ++j) {
            const float sft = cf[j] + mul[j] * (pf[j] - cf[j]);
            const float sg = frcp(1.f + __expf(-act_s * sft));
            lv[j] = lseg < 64 ? 2.f * sg - 1.f : (lseg >= 128 ? sg : sft);
          }
          u32x4 w0 = {pack2(lv[0], lv[1]), pack2(lv[2], lv[3]), pack2(lv[4], lv[5]), pack2(lv[6], lv[7])};
          *(u32x4*)(base + (st << 10) + swz(et, c4 + hf)) = w0;
        }
      }
      if (tb + 32 < T) SCAN_LOAD(t0 + 32);
    }
    __syncthreads();
    {
      f32x4 dw = {0.f, 0.f, 0.f, 0.f}, da = dw, dg = dw;
#pragma unroll
      for (int ks = 0; ks < 2; ++ks) {
        bf16x8 aw = *(const bf16x8*)(sTW + (ks << 10) + swz(r, q));
        bf16x8 aa = *(const bf16x8*)(sAL + (ks << 10) + swz(r, q));
        dw = mfma16(aw, bw[ks], dw);
        da = mfma16(aa, ba[ks], da);
      }
#pragma unroll
      for (int ks = 0; ks < 4; ++ks) {
        bf16x8 ag = *(const bf16x8*)(sSG + (ks << 10) + swz(r, q));
        dg = mfma16(ag, bg[ks], dg);
      }
      const int ch = wave * 16 + r;
#pragma unroll
      for (int jj = 0; jj < 4; ++jj) {
        const int tk = q * 4 + jj;
        float z = -(w0c + dw[jj]);
        float sp = z > 20.f ? z : __logf(1.f + __expf(z));
        float logw = -sp - 0.5f;
        sW[tk * 64 + ch] = __expf(-__expf(logw));
        sKKA[tk * 64 + ch] = sigmoidf_(a0c + da[jj]);
        sG[tk * 64 + ch] = dg[jj];
      }
    }
    __syncthreads();
    {
      float kkw[4], kaw[4], rkw[4];
      {
        const float4 a4 = *(const float4*)(p.in[19] + hc), b4 = *(const float4*)(p.in[20] + hc), c4v = *(const float4*)(p.in[21] + hc);
        kkw[0] = a4.x; kkw[1] = a4.y; kkw[2] = a4.z; kkw[3] = a4.w;
        kaw[0] = b4.x; kaw[1] = b4.y; kaw[2] = b4.z; kaw[3] = b4.w;
        rkw[0] = c4v.x; rkw[1] = c4v.y; rkw[2] = c4v.z; rkw[3] = c4v.w;
      }
      float4 k4 = *(const float4*)(sKp + et * 64 + ec);
      float4 a4 = *(const float4*)(sKKA + et * 64 + ec);
      float4 r4 = *(const float4*)(sR + et * 64 + ec);
      float kr[4] = {k4.x, k4.y, k4.z, k4.w}, aa[4] = {a4.x, a4.y, a4.z, a4.w}, rr[4] = {r4.x, r4.y, r4.z, r4.w};
      float kk[4], ss = 0.f;
#pragma unroll
      for (int j = 0; j < 4; ++j) { kk[j] = kr[j] * kkw[j]; ss += kk[j] * kk[j]; }
      ss = row16_sum(ss);
      const float inv = fminf(__builtin_amdgcn_rsqf(ss), 1e12f);
      float kp[4], nk[4], ka[4], rk = 0.f;
#pragma unroll
      for (int j = 0; j < 4; ++j) {
        kk[j] *= inv;
        kp[j] = kr[j] * (1.f + (aa[j] - 1.f) * kaw[j]);
        nk[j] = -kk[j]; ka[j] = kk[j] * aa[j];
        rk += rr[j] * kp[j] * rkw[j];
      }
      rk = row16_sum(rk);
      *(float4*)(sKp + et * 64 + ec) = make_float4(kp[0], kp[1], kp[2], kp[3]);
      *(float4*)(sNKK + et * 64 + ec) = make_float4(nk[0], nk[1], nk[2], nk[3]);
      *(float4*)(sKKA + et * 64 + ec) = make_float4(ka[0], ka[1], ka[2], ka[3]);
      if ((tid & 15) == 0) sRK[et] = rk;
    }
    __syncthreads();
    {
      const int k = tid & 63, tq = tid >> 6;
      float gam = 1.f;
      {
        float wv[12];
#pragma unroll
        for (int t = 0; t < 12; ++t) wv[t] = sW[t * 64 + k];
#pragma unroll
        for (int t = 0; t < 12; ++t) gam *= (t < 4 * tq) ? wv[t] : 1.f;
      }
      float bt[4], kt[4];
#pragma unroll
      for (int i = 0; i < 4; ++i) {
        const int t = 4 * tq + i;
        const float gprev = gam;
        gam *= sW[t * 64 + k];
        const float ginv = frcp(gam);
        const float av = sNKK[t * 64 + k] * gprev;
        const float rv = sR[t * 64 + k] * gam;
        bt[i] = sKKA[t * 64 + k] * ginv;
        kt[i] = sKp[t * 64 + k] * ginv;
        *(u16*)(imgA + t * 144 + k * 2) = f2bf(av);
        *(u16*)(imgR + t * 144 + k * 2) = f2bf(rv);
        *(u16*)(imgB + t * 144 + k * 2) = f2bf(bt[i]);
        *(u16*)(imgK + t * 144 + k * 2) = f2bf(kt[i]);
      }
      u32x2 bv = {pack2(bt[0], bt[1]), pack2(bt[2], bt[3])};
      u32x2 kv = {pack2(kt[0], kt[1]), pack2(kt[2], kt[3])};
      *(u32x2*)(sBKT + k * 72 + tq * 8) = bv;
      *(u32x2*)(sBKT + k * 72 + 32 + tq * 8) = kv;
      if (tq == 3) sGam[k] = gam;
    }
    __syncthreads();
    {
      const unsigned char* Limg = (wave & 1) ? imgK : imgB;
      const unsigned char* Rimg = (wave & 2) ? imgR : imgA;
      f32x4 d = {0.f, 0.f, 0.f, 0.f};
#pragma unroll
      for (int ks = 0; ks < 2; ++ks) {
        bf16x8 lf = *(const bf16x8*)(Limg + r * 144 + ks * 64 + q * 16);
        bf16x8 rf = *(const bf16x8*)(Rimg + r * 144 + ks * 64 + q * 16);
        d = mfma16(lf, rf, d);
      }
      float x[4];
#pragma unroll
      for (int jj = 0; jj < 4; ++jj) {
        const int i = 4 * q + jj;
        const bool keep = (wave & 2) ? (i <= r) : (i < r);
        x[jj] = keep ? d[jj] : 0.f;
      }
      u32x2 xv = {pack2(x[0], x[1]), pack2(x[2], x[3])};
      *(u32x2*)(sMAT + wave * 640 + r * 40 + q * 8) = xv;
      if (wave == 0) {
#pragma unroll
        for (int jj = 0; jj < 4; ++jj) sNab[(4 * q + jj) * 16 + r] = x[jj];
      }
    }
    if (wave == 0) {
      float c[16];
#pragma unroll
      for (int i = 0; i < 16; ++i) c[i] = (i == r) ? 1.f : 0.f;
      int dep = 0;
#pragma unroll
      for (int ig = 14; ig >= 0; ig -= 2) {
        const float* nb = sNab + dep;
#pragma unroll
        for (int i = ig; i > ig - 2 && i >= 0; --i) {
          float acc0 = c[i], acc1 = 0.f;
#pragma unroll
          for (int j = i + 1; j < 16; ++j) { if ((j - i) & 1) acc0 += nb[i * 16 + j] * c[j]; else acc1 += nb[i * 16 + j] * c[j]; }
          c[i] = acc0 + acc1;
        }
        asm volatile("v_mov_b32 %0, 0" : "=v"(dep) : "v"(c[ig > 0 ? ig - 1 : 0]));
      }
      float tc[4];
      const float qm0 = q == 0 ? 1.f : 0.f, qm1 = q == 1 ? 1.f : 0.f, qm2 = q == 2 ? 1.f : 0.f, qm3 = q == 3 ? 1.f : 0.f;
#pragma unroll
      for (int e = 0; e < 4; ++e) tc[e] = qm0 * c[e] + qm1 * c[4 + e] + qm2 * c[8 + e] + qm3 * c[12 + e];
      { u32x2 tv = {pack2(tc[0], tc[1]), pack2(tc[2], tc[3])}; *(u32x2*)(sTT + r * 40 + q * 8) = tv; }
    }
    __syncthreads();
    if (hf == 0) {
#pragma unroll 1
      for (int cc = 0; cc < 2; ++cc) {
        if (cc == 1 && tb + 16 >= T) break;
        unsigned char* rb = smem0 + cc * 61440;
        const unsigned char* c_imgA = rb + 41216;
        const unsigned char* c_imgR = rb + 43520;
        const unsigned char* c_BKT = rb + 50432;
        const unsigned char* c_MAT = rb + 55040;
        const float* c_Gam = (const float*)(rb + 58624);
        const unsigned char* c_TT = rb + 58880;
        const float* c_V = (const float*)(rb + 20480);
        float* c_Y = (float*)(rb + 28672);
        u32x4 w;
        bf16x8 sfr[2];
#pragma unroll
        for (int ks = 0; ks < 2; ++ks) {
          w = (u32x4){pack2(S[2 * ks][0], S[2 * ks][1]), pack2(S[2 * ks][2], S[2 * ks][3]),
                      pack2(S[2 * ks + 1][0], S[2 * ks + 1][1]), pack2(S[2 * ks + 1][2], S[2 * ks + 1][3])};
          sfr[ks] = __builtin_bit_cast(bf16x8, w);
        }
        float vv[4];
#pragma unroll
        for (int e = 0; e < 4; ++e) vv[e] = c_V[(4 * q + e) * 64 + vme];
        const u32x2 vpk = {pack2(vv[0], vv[1]), pack2(vv[2], vv[3])};
        f32x4 rhs = {0.f, 0.f, 0.f, 0.f};
#pragma unroll
        for (int ks = 0; ks < 2; ++ks) {
          u32x2 lo = *(const u32x2*)(c_imgA + r * 144 + (32 * ks + 4 * q) * 2);
          u32x2 hi = *(const u32x2*)(c_imgA + r * 144 + (32 * ks + 16 + 4 * q) * 2);
          w = (u32x4){lo[0], lo[1], hi[0], hi[1]};
          rhs = mfma16(__builtin_bit_cast(bf16x8, w), sfr[ks], rhs);
        }
        {
          u32x2 nk = *(const u32x2*)(c_MAT + 1 * 640 + r * 40 + q * 8);
          w = (u32x4){nk[0], nk[1], 0u, 0u};
          u32x4 wb = {vpk[0], vpk[1], 0u, 0u};
          rhs = mfma16(__builtin_bit_cast(bf16x8, w), __builtin_bit_cast(bf16x8, wb), rhs);
        }
        f32x4 ut = {0.f, 0.f, 0.f, 0.f};
        {
          u32x2 tv = *(const u32x2*)(c_TT + r * 40 + q * 8);
          w = (u32x4){tv[0], tv[1], 0u, 0u};
          u32x4 wb = {pack2(rhs[0], rhs[1]), pack2(rhs[2], rhs[3]), 0u, 0u};
          ut = mfma16(__builtin_bit_cast(bf16x8, w), __builtin_bit_cast(bf16x8, wb), ut);
        }
        const u32x4 uvb = {pack2(ut[0], ut[1]), pack2(ut[2], ut[3]), vpk[0], vpk[1]};
        const bf16x8 uvf = __builtin_bit_cast(bf16x8, uvb);
        f32x4 yt = {0.f, 0.f, 0.f, 0.f};
#pragma unroll
        for (int ks = 0; ks < 2; ++ks) {
          u32x2 lo = *(const u32x2*)(c_imgR + r * 144 + (32 * ks + 4 * q) * 2);
          u32x2 hi = *(const u32x2*)(c_imgR + r * 144 + (32 * ks + 16 + 4 * q) * 2);
          w = (u32x4){lo[0], lo[1], hi[0], hi[1]};
          yt = mfma16(__builtin_bit_cast(bf16x8, w), sfr[ks], yt);
        }
        {
          u32x2 mb = *(const u32x2*)(c_MAT + 2 * 640 + r * 40 + q * 8);
          u32x2 mk = *(const u32x2*)(c_MAT + 3 * 640 + r * 40 + q * 8);
          w = (u32x4){mb[0], mb[1], mk[0], mk[1]};
          yt = mfma16(__builtin_bit_cast(bf16x8, w), uvf, yt);
        }
#pragma unroll
        for (int jj = 0; jj < 4; ++jj) c_Y[(4 * q + jj) * 64 + vme] = yt[jj];
#pragma unroll
        for (int g = 0; g < 4; ++g) {
          u32x2 bb = *(const u32x2*)(c_BKT + (16 * g + r) * 72 + q * 8);
          u32x2 kb = *(const u32x2*)(c_BKT + (16 * g + r) * 72 + 32 + q * 8);
          w = (u32x4){bb[0], bb[1], kb[0], kb[1]};
          f32x4 ds = {0.f, 0.f, 0.f, 0.f};
          ds = mfma16(__builtin_bit_cast(bf16x8, w), uvf, ds);
          const float4 gm = *(const float4*)(c_Gam + 16 * g + 4 * q);
          S[g][0] = (S[g][0] + ds[0]) * gm.x; S[g][1] = (S[g][1] + ds[1]) * gm.y;
          S[g][2] = (S[g][2] + ds[2]) * gm.z; S[g][3] = (S[g][3] + ds[3]) * gm.w;
        }
      }
    }
    __syncthreads();
    {
      float lnw[4], lnb[4];
      {
        const float4 a4 = *(const float4*)(p.in[22] + hc), b4 = *(const float4*)(p.in[23] + hc);
        lnw[0] = a4.x; lnw[1] = a4.y; lnw[2] = a4.z; lnw[3] = a4.w;
        lnb[0] = b4.x; lnb[1] = b4.y; lnb[2] = b4.z; lnb[3] = b4.w;
      }
      float4 y4 = *(const float4*)(sY + et * 64 + ec);
      float yy[4] = {y4.x, y4.y, y4.z, y4.w};
      float s1 = row16_sum(yy[0] + yy[1] + yy[2] + yy[3]);
      const float mean = s1 * (1.f / 64.f);
      float s2 = 0.f;
#pragma unroll
      for (int j = 0; j < 4; ++j) { yy[j] -= mean; s2 += yy[j] * yy[j]; }
      s2 = row16_sum(s2);
      const float rs = __builtin_amdgcn_rsqf(s2 * (1.f / 64.f) + 64e-5f);
      const float rk = sRK[et];
      float4 v4 = *(const float4*)(sV + et * 64 + ec);
      float4 g4 = *(const float4*)(sG + et * 64 + ec);
      const float vv[4] = {v4.x, v4.y, v4.z, v4.w}, gg[4] = {g4.x, g4.y, g4.z, g4.w};
      float o[4];
#pragma unroll
      for (int j = 0; j < 4; ++j) o[j] = (yy[j] * rs * lnw[j] + lnb[j] + rk * vv[j]) * gg[j];
      u32x2 ov = {pack2(o[0], o[1]), pack2(o[2], o[3])};
      if (t0 < T) *(u32x2*)(MIX + (size_t)(row0 + t0 + et) * 1024 + hc) = ov;
    }
    __syncthreads();
  }
  if (hf == 0) {
    float* so = is_p ? p.out + O_WKVP + ((size_t)stream * 8 + h) * 4096 : p.out + O_WKVS + ((size_t)(stream - 16) * 8 + h) * 4096;
#pragma unroll
    for (int g = 0; g < 4; ++g) *(float4*)(so + vme * 64 + g * 16 + q * 4) = make_float4(S[g][0], S[g][1], S[g][2], S[g][3]);
  }
}

__device__ __forceinline__ void phase_mix(const Params& p, unsigned char* smem, int qslot) {
  __shared__ int s_item;
  int* counter = (int*)(p.ws + WS_ZERO) + qslot;
  const int N_SCANP = 128, N_ATTS = 64, N_ATTP = 2048, N_SCANS = 64, N_ATTM = 128;
  const int total = N_SCANP + N_ATTS + N_ATTP + N_SCANS + N_ATTM;
  const u16* Q = (const u16*)(p.ws + WS_Q);
  const u16* KALL = (const u16*)(p.ws + WS_KALL);
  u16* MIX = (u16*)(p.ws + WS_MIX);
  while (true) {
    __syncthreads();
    if (threadIdx.x == 0) s_item = atomicAdd(counter, 1);
    __syncthreads();
    int it = s_item;
    if (it >= total) break;
    bool is_scan = false; int sc_stream = 0, sc_h = 0;
    AttnItem a{};
    if (it < N_SCANP) { is_scan = true; sc_stream = it >> 3; sc_h = it & 7; }
    else if (it < N_SCANP + N_ATTS) {
      it -= N_SCANP;
      const int bd = it >> 3, h = it & 7;
      a.Q = Q + (size_t)(M_P + bd * 64) * 768 + h * 96;
      a.Kb = KALL + (size_t)(M_TOT + bd * KS_S) * 768 + h * 96;
      a.Vt = (const u16*)(p.ws + WS_VTS) + ((size_t)bd * 512 + h * 64) * TPAD_S; a.ldv = TPAD_S;
      a.O = MIX + (size_t)(M_P + bd * 64) * 1024 + 512 + h * 64;
      a.nq_valid = 64; a.ntiles = 33; a.wt_base = 33; a.wt_step = 0;
    } else if (it < N_SCANP + N_ATTS + N_ATTP) {
      it -= N_SCANP + N_ATTS;
      const int j = 15 - (it >> 7), bh = it & 127, b = bh >> 3, h = bh & 7;
      const size_t qrow = (size_t)b * TP + 16 + 256 * j;
      a.Q = Q + qrow * 768 + h * 96;
      a.Kb = KALL + (size_t)b * TP * 768 + h * 96;
      a.Vt = (const u16*)(p.ws + WS_VTP) + ((size_t)b * 512 + h * 64) * TPAD_P; a.ldv = TPAD_P;
      a.O = MIX + qrow * 1024 + 512 + h * 64;
      a.nq_valid = 256; a.ntiles = 4 * j + 4; a.wt_base = 4 * j + 1; a.wt_step = 1;
    } else if (it < N_SCANP + N_ATTS + N_ATTP + N_SCANS) {
      it -= N_SCANP + N_ATTS + N_ATTP;
      is_scan = true; sc_stream = 16 + (it >> 3); sc_h = it & 7;
    } else {
      it -= N_SCANP + N_ATTS + N_ATTP + N_SCANS;
      const int b = it >> 3, h = it & 7;
      const size_t qrow = (size_t)b * TP;
      a.Q = Q + qrow * 768 + h * 96;
      a.Kb = KALL + (size_t)b * TP * 768 + h * 96;
      a.Vt = (const u16*)(p.ws + WS_VTP) + ((size_t)b * 512 + h * 64) * TPAD_P; a.ldv = TPAD_P;
      a.O = MIX + qrow * 1024 + 512 + h * 64;
      a.nq_valid = 16; a.ntiles = 0; a.wt_base = 0; a.wt_step = 0;
    }
    if (is_scan) scan_item(p, sc_stream, sc_h, smem);
    else attn_item(a, smem);
  }
}

__device__ __forceinline__ void phase_final(const Params& p) {
  const float* ssq4 = (const float*)(p.ws + WS_ZERO + 256) + 3 * (size_t)M_TOT;
  const float* gf = p.in[34];
  const int lane = threadIdx.x & 63, wave = threadIdx.x >> 6;
  const int rstride = gridDim.x * NWAVES;
  for (int orow0 = blockIdx.x * NWAVES + wave; orow0 < 65536 + 512; orow0 += 2 * rstride) {
    float* y[2]; const u16* xrow[2]; float rs[2]; bool ok[2];
#pragma unroll
    for (int u = 0; u < 2; ++u) {
      int orow = orow0 + u * rstride; ok[u] = orow < 65536 + 512; if (!ok[u]) orow = orow0;
      int row;
      if (orow < 65536) { int b = orow >> 12, f = orow & 4095; row = b * TP + 16 + f; y[u] = p.out + O_YP + (size_t)orow * 1024; }
      else { row = M_P + (orow - 65536); y[u] = p.out + O_YS + (size_t)(orow - 65536) * 1024; }
      rs[u] = rsqrtf(ssq4[row] * (1.f / 1024.f) + 1e-6f);
      xrow[u] = (const u16*)(p.ws + WS_XB) + (size_t)row * D;
    }
    u32x2 v[2][4];
#pragma unroll
    for (int u = 0; u < 2; ++u)
#pragma unroll
      for (int i = 0; i < 4; ++i) v[u][i] = *(const u32x2*)(xrow[u] + i * 256 + lane * 4);
#pragma unroll
    for (int u = 0; u < 2; ++u)
#pragma unroll
      for (int i = 0; i < 4; ++i) {
        const float4 g = *(const float4*)(gf + i * 256 + lane * 4);
        float4 t;
        t.x = bflo(v[u][i][0]) * rs[u] * g.x; t.y = bfhi(v[u][i][0]) * rs[u] * g.y;
        t.z = bflo(v[u][i][1]) * rs[u] * g.z; t.w = bfhi(v[u][i][1]) * rs[u] * g.w;
        if (ok[u]) *(float4*)(y[u] + i * 256 + lane * 4) = t;
      }
  }
}

__device__ __forceinline__ void run_phase(const Params& p, int ph, unsigned char* smem, int qslot, const XcdInfo xi) {
  float* ssq = (float*)(p.ws + WS_ZERO + 256);
  u16* XB = (u16*)(p.ws + WS_XB);
  u16* ACT = (u16*)(p.ws + WS_ACT);
  switch (ph) {
#if PH_ON(0)
    case 0: phase_prep(p, smem); break;
#endif
#if PH_ON(1)
    case 1: {
      GemmArgs g{XB, D, (const u16*)(p.ws + WS_W13A), D, D};
      EpiArgs e{}; e.ssq_in = ssq; e.dst = ACT; e.ldd = DFF;
      gemm_phase<EPI_FFNUP, 8>(g, e, 256, 22, smem, xi, NCH_UP);
      gemm_phase<EPI_FFNUP, 4>(g, e, 6, 22, smem, xi, NCH_UP, 65536);
    } break;
#endif
#if PH_ON(2)
    case 2: {
      GemmArgs g{ACT, DFF, (const u16*)(p.ws + WS_W2A), DFF, DFF};
      EpiArgs e{}; e.ssq_out = ssq + M_TOT; e.dst = XB; e.ldd = D; e.alpha = 0.5f;
      gemm_phase<EPI_RESID, 8>(g, e, 256, 4, smem, xi, NCH_DOWN);
      gemm_phase<EPI_RESID, 4>(g, e, 6, 4, smem, xi, NCH_DOWN, 65536);
    } break;
#endif
#if PH_ON(3)
    case 3: {
      GemmArgs g{XB, D, (const u16*)(p.ws + WS_WIN), D, D};
      EpiArgs e{}; e.ssq_in = ssq + M_TOT; e.dst = (u16*)(p.ws + WS_P); e.ldd = NIN; e.out = p.out;
      gemm_phase<EPI_WIN, 8>(g, e, 256, 9, smem, xi, NCH_WIN);
      gemm_phase<EPI_WIN, 4>(g, e, 6, 9, smem, xi, NCH_WIN, 65536);
    } break;
#endif
#if PH_ON(4)
    case 4: phase_mla_prep(p); break;
#endif
#if PH_ON(5)
    case 5: phase_mla_gemms(p, smem); break;
#endif
#if PH_ON(6)
    case 6: phase_mix(p, smem, qslot); break;
#endif
#if PH_ON(7)
    case 7: {
      GemmArgs g{(const u16*)(p.ws + WS_MIX), D, (const u16*)(p.ws + WS_WOUT), D, D};
      EpiArgs e{}; e.ssq_out = ssq + 2 * (size_t)M_TOT; e.dst = XB; e.ldd = D; e.alpha = 1.f;
      gemm_phase<EPI_RESID, 8>(g, e, 256, 4, smem, xi, NCH_OUT);
      gemm_phase<EPI_RESID, 4>(g, e, 6, 4, smem, xi, NCH_OUT, 65536);
    } break;
#endif
#if PH_ON(8)
    case 8: {
      GemmArgs g{XB, D, (const u16*)(p.ws + WS_W13B), D, D};
      EpiArgs e{}; e.ssq_in = ssq + 2 * (size_t)M_TOT; e.dst = ACT; e.ldd = DFF;
      gemm_phase<EPI_FFNUP, 8>(g, e, 256, 22, smem, xi, NCH_UP);
      gemm_phase<EPI_FFNUP, 4>(g, e, 6, 22, smem, xi, NCH_UP, 65536);
    } break;
#endif
#if PH_ON(9)
    case 9: {
      GemmArgs g{ACT, DFF, (const u16*)(p.ws + WS_W2B), DFF, DFF};
      EpiArgs e{}; e.ssq_out = ssq + 3 * (size_t)M_TOT; e.dst = XB; e.ldd = D; e.alpha = 0.5f; e.out = p.out;
      gemm_phase<EPI_RESID, 8>(g, e, 256, 4, smem, xi, NCH_DOWN);
      gemm_phase<EPI_RESID, 4>(g, e, 6, 4, smem, xi, NCH_DOWN, 65536);
    } break;
#endif
#if PH_ON(10)
    case 10: phase_final(p); break;
#endif
  }
}


#define XB_TMO      128
#define XB_XCNT(j)  (256  + 64 * (j))
#define XB_XSUB(j)  (1280 + 64 * (j))
#define XB_XGEN(j)  (2304 + 64 * (j))
#define XB_TOP      3328
#define XB_TOPGEN   3392
#define XB_SPIN_CAP (1u << 20)
#define LAS __attribute__((address_space(3)))
__device__ __forceinline__ unsigned xb_ld(unsigned* p)              { return __hip_atomic_load(p, __ATOMIC_RELAXED, __HIP_MEMORY_SCOPE_AGENT); }
__device__ __forceinline__ unsigned xb_add(unsigned* p, unsigned v) { return __hip_atomic_fetch_add(p, v, __ATOMIC_RELAXED, __HIP_MEMORY_SCOPE_AGENT); }
__device__ __forceinline__ unsigned xb_xcc_id() { return (unsigned)__builtin_amdgcn_s_getreg((3 << 11) | 20) & 0xFu; }
#define XB_SPIN(cond, bar) do { unsigned _sp = 0; while (cond) { __builtin_amdgcn_s_sleep(1); \
    if ((++_sp & 255u) == 0u) { if (xb_ld(&(bar)[XB_TMO])) break; if (_sp > XB_SPIN_CAP) { atomicAdd(&(bar)[XB_TMO], 1u); break; } } } } while (0)
struct XcdBarrier { unsigned* bar; unsigned x; volatile LAS unsigned* st; };
__device__ __forceinline__ XcdBarrier xcd_barrier_post(unsigned* bar, volatile LAS unsigned* st) {
    XcdBarrier b; b.bar = bar; b.x = xb_xcc_id(); b.st = st;
    if (threadIdx.x == 0) (void)xb_add(&bar[XB_XCNT(b.x)], 1u);
    return b;
}
__device__ __forceinline__ void xcd_barrier_complete(unsigned* bar, unsigned x, unsigned& nloc, unsigned& nx) {
    const unsigned G = gridDim.x * gridDim.y * gridDim.z;
    unsigned sum, cnt, mine, sp = 0u;
    for (;;) {
        sum = 0u; cnt = 0u; mine = 0u;
#pragma unroll
        for (unsigned j = 0; j < 16; ++j) { const unsigned c = xb_ld(&bar[XB_XCNT(j)]); sum += c; cnt += (c > 0u) ? 1u : 0u; mine = (j == x) ? c : mine; }
        if (sum == G) break;
        __builtin_amdgcn_s_sleep(1);
        if ((++sp & 255u) == 0u) { if (xb_ld(&bar[XB_TMO])) break; if (sp > XB_SPIN_CAP) { atomicAdd(&bar[XB_TMO], 1u); break; } }
    }
    nloc = mine > 0u ? mine : 1u; nx = cnt > 0u ? cnt : 1u;
}
__device__ __forceinline__ void xcd_barrier(const XcdBarrier& b) {
    asm volatile("s_waitcnt vmcnt(0)" ::: "memory");
    __syncthreads();
    if (threadIdx.x == 0) {
        unsigned* bar = b.bar;
        __builtin_amdgcn_s_waitcnt(0);
        unsigned nloc = b.st[0], nx = b.st[1];
        if (nloc == 0u) { xcd_barrier_complete(bar, b.x, nloc, nx); b.st[0] = nloc; b.st[1] = nx; }
        const unsigned old = xb_add(&bar[XB_XSUB(b.x)], 1u);
        const unsigned gen = old / nloc;
        if (old + 1u == (gen + 1u) * nloc) {
            __builtin_amdgcn_fence(__ATOMIC_RELEASE, "agent");
            asm volatile("s_waitcnt vmcnt(0)" ::: "memory");
            const unsigned og = xb_add(&bar[XB_TOP], 1u);
            const unsigned tg = og / nx;
            if (og + 1u == (tg + 1u) * nx) xb_add(&bar[XB_TOPGEN], 1u);
            else XB_SPIN(xb_ld(&bar[XB_TOPGEN]) == tg, bar);
            __builtin_amdgcn_fence(__ATOMIC_ACQUIRE, "agent");
            xb_add(&bar[XB_XGEN(b.x)], 1u);
            asm volatile("s_waitcnt vmcnt(0)" ::: "memory");
        } else {
            XB_SPIN(xb_ld(&bar[XB_XGEN(b.x)]) == gen, bar);
            __builtin_amdgcn_fence(__ATOMIC_ACQUIRE, "agent");
            asm volatile("s_waitcnt vmcnt(0)" ::: "memory");
        }
    }
    __syncthreads();
}

__global__ void __launch_bounds__(NTHREADS, 2) mega(Params p, int ph_lo, int ph_hi) {
  __shared__ __attribute__((aligned(16))) unsigned char smem[SMEM_BYTES];
  cg::grid_group grid = cg::this_grid();
  __shared__ int s_xi[2];
  int* xcnt = (int*)(p.ws + WS_ZERO) + 16;
  if (threadIdx.x == 0) {
    const int xcc = __builtin_amdgcn_s_getreg(0x1814) & 7;
    s_xi[0] = xcc;
    s_xi[1] = atomicAdd(xcnt + xcc, 1);
  }
  XcdInfo xi{(int)(blockIdx.x & 7), (int)(blockIdx.x >> 3), (gridDim.x & 7) == 0 ? (int)(gridDim.x >> 3) : 0};
  __shared__ __attribute__((aligned(16))) unsigned xb_words[4];
  if (threadIdx.x == 0) { xb_words[0] = 0u; xb_words[1] = 0u; }
  __syncthreads();
  const XcdBarrier xb = xcd_barrier_post((unsigned*)(p.ws + WS_XBAR), (volatile LAS unsigned*)&xb_words);
#ifndef PROBE_DBL
#define PROBE_DBL 0
#endif
#define RUN_PH(X) if (ph_lo <= X && X <= ph_hi) { if ((PROBE_DBL >> X) & 1) { run_phase(p, X, smem, 1, xi); grid.sync(); } run_phase(p, X, smem, 0, xi); if (X < ph_hi) { if (X == 0) grid.sync(); else xcd_barrier(xb); } }
  RUN_PH(0)
  if (ph_lo == 0 && ph_hi > 0) {
    int c0 = __hip_atomic_load(xcnt, __ATOMIC_RELAXED, __HIP_MEMORY_SCOPE_AGENT);
    bool even = c0 > 0 && c0 * 8 == (int)gridDim.x;
#pragma unroll
    for (int i = 1; i < 8; ++i) even = even && (__hip_atomic_load(xcnt + i, __ATOMIC_RELAXED, __HIP_MEMORY_SCOPE_AGENT) == c0);
    if (even) { xi.xcd = s_xi[0]; xi.slot = s_xi[1]; xi.nbx = c0; }
  }
  RUN_PH(1) RUN_PH(2) RUN_PH(3) RUN_PH(4) RUN_PH(5) RUN_PH(6) RUN_PH(7) RUN_PH(8) RUN_PH(9) RUN_PH(10)
}

extern "C" void kernel_launch(void* const* d_in, const int* in_sizes, int n_in, void* d_out, int out_size,
                              void* d_ws, size_t ws_size, hipStream_t stream) {
  static int grid_blocks = 0;
  if (!grid_blocks) {
    int dev = 0, cus = 0, per_cu = 0;
    hipGetDevice(&dev);
    hipDeviceGetAttribute(&cus, hipDeviceAttributeMultiprocessorCount, dev);
    hipOccupancyMaxActiveBlocksPerMultiprocessor(&per_cu, mega, NTHREADS, 0);
    if (per_cu > 1) per_cu = 1;
    if (per_cu < 1) per_cu = 1;
    grid_blocks = cus * per_cu;
  }
  Params p{};
  for (int i = 0; i < 35; ++i) p.in[i] = (const float*)d_in[i];
  p.out = (float*)d_out;
  p.ws = (unsigned char*)d_ws;
  hipMemsetAsync((unsigned char*)d_ws + WS_ZERO, 0, ZERO_BYTES, stream);
#if ONE_LAUNCH
  int lo = 0, hi = 10;
  void* args[] = {&p, &lo, &hi};
  hipError_t e = hipLaunchCooperativeKernel((void*)mega, dim3(grid_blocks), dim3(NTHREADS), args, 0, stream);
  if (e != hipSuccess) fprintf(stderr, "cooperative launch failed: %s (grid %d)\n", hipGetErrorString(e), grid_blocks);
#else
  for (int ph = 0; ph <= 10; ++ph) {
    int lo = ph, hi = ph;
    void* args[] = {&p, &lo, &hi};
    hipError_t e = hipLaunchCooperativeKernel((void*)mega, dim3(grid_blocks), dim3(NTHREADS), args, 0, stream);
    if (e != hipSuccess) fprintf(stderr, "cooperative launch failed: %s (grid %d)\n", hipGetErrorString(e), grid_blocks);
  }
#endif
}
```
